# Optimizing an MI355X kernel written in HIP

```python
import jax, jax.numpy as jnp
from jax import lax
import numpy as np

D_MODEL = 1024
BATCH = 8
SEQ = 2048
DEPTH = 2
DEC_BATCH = 128
DEC_SEQ = 8
PAST_LEN = 16384
PAGE_SIZE = 128

N_EVEN = (DEPTH + 1) // 2
N_ODD = DEPTH // 2
EPS = 1e-6

SGU_CHUNK = 128
SGU_GROUPS = 4
SGU_WIDTH = D_MODEL
SGU_GROUP_DIM = SGU_WIDTH // SGU_GROUPS
RET_HEADS = 4
RET_DK = D_MODEL // 8
RET_DV = D_MODEL // 4
RET_CHUNK = 128
RET_ROPE_BASE = 10000.0
C_HEADS = 16
C_KV_HEADS = 4
C_HEAD_DIM = D_MODEL // C_HEADS
C_GROUP = C_HEADS // C_KV_HEADS
WINDOW = 128
C_ROPE_BASE = 150000.0
N_MEM = 256
MEM_HEADS = 4
MEM_HEAD_DIM = D_MODEL // MEM_HEADS
D_FF = 4 * D_MODEL

EVEN_SPLITS = (SGU_WIDTH, 2 * SGU_WIDTH, 2 * SGU_WIDTH + RET_HEADS * RET_DK,
               2 * SGU_WIDTH + 2 * RET_HEADS * RET_DK,
               2 * SGU_WIDTH + 2 * RET_HEADS * RET_DK + RET_HEADS * RET_DV)
EVEN_IN = 2 * SGU_WIDTH + 2 * RET_HEADS * RET_DK + 2 * RET_HEADS * RET_DV
EVEN_OUT = SGU_WIDTH + RET_HEADS * RET_DV
ODD_SPLITS = (C_HEADS * C_HEAD_DIM, (C_HEADS + C_KV_HEADS) * C_HEAD_DIM)
ODD_IN = (C_HEADS + 2 * C_KV_HEADS) * C_HEAD_DIM

kernel_name = 'hybrid_sgu_retention_swa_decoder_step'


def rms_norm(x, g):
    xf = x.astype(jnp.float32)
    y = xf * lax.rsqrt(jnp.mean(xf * xf, axis=-1, keepdims=True) + EPS)
    return (y * g.astype(jnp.float32)).astype(x.dtype)


def layer_norm(x, g, b):
    xf = x.astype(jnp.float32)
    mu = jnp.mean(xf, axis=-1, keepdims=True)
    xc = xf - mu
    y = xc * lax.rsqrt(jnp.mean(xc * xc, axis=-1, keepdims=True) + EPS)
    return (y * g.astype(jnp.float32) + b.astype(jnp.float32)).astype(x.dtype)


def rotary(x, pos, base):
    half = x.shape[-1] // 2
    inv = base ** (-jnp.arange(half, dtype=jnp.float32) / half)
    ang = pos.astype(jnp.float32)[:, None] * inv[None, :]
    cos = jnp.cos(ang)[None, :, None, :]
    sin = jnp.sin(ang)[None, :, None, :]
    xf = x.astype(jnp.float32)
    x1, x2 = xf[..., :half], xf[..., half:]
    return jnp.concatenate([x1 * cos - x2 * sin, x1 * sin + x2 * cos], axis=-1).astype(x.dtype)


def sgu_mix(u, v, ln_g, ln_b, w_s, b_s):
    b, l, _ = u.shape
    vn = layer_norm(v, ln_g, ln_b)
    c = SGU_CHUNK if l % SGU_CHUNK == 0 else l
    nc = l // c
    mask = jnp.tril(jnp.ones((c, c), dtype=bool))
    w = jnp.where(mask[None], w_s[:, :c, :c], 0).astype(v.dtype)
    vc = vn.reshape(b, nc, c, SGU_GROUPS, SGU_GROUP_DIM)
    mixed = jnp.einsum('gts,bnsgd->bntgd', w, vc) + b_s[:, :c].T[None, None, :, :, None].astype(v.dtype)
    out = u * mixed.reshape(b, l, SGU_WIDTH)
    return out, vc.reshape(b, l, SGU_GROUPS, SGU_GROUP_DIM)


def retention(q, k, v, s0):
    b, l, h, _ = q.shape
    c = RET_CHUNK if l % RET_CHUNK == 0 else l
    nc = l // c
    lg = jnp.log1p(-jnp.exp2(-5.0 - jnp.arange(h, dtype=jnp.float32)))
    idx = jnp.arange(c, dtype=jnp.float32)
    diff = idx[:, None] - idx[None, :]
    decay = jnp.where(diff >= 0, jnp.exp(jnp.maximum(diff, 0.0)[None] * lg[:, None, None]), 0.0)
    xi = jnp.exp((idx[:, None] + 1.0) * lg[None, :])
    zeta = jnp.exp((c - 1.0 - idx)[:, None] * lg[None, :])
    chunk_decay = jnp.exp(c * lg)

    def to_chunks(t):
        return t.astype(jnp.float32).reshape(b, nc, c, h, t.shape[-1]).transpose(1, 0, 2, 3, 4)

    def step(s, inp):
        qc, kc, vc = inp
        sc = jnp.einsum('bihd,bjhd->bhij', qc, kc) * decay
        o = (jnp.einsum('bhij,bjhe->bihe', sc, vc)
             + jnp.einsum('bihd,bhde->bihe', qc, s) * xi[None, :, :, None])
        s = s * chunk_decay[:, None, None] + jnp.einsum('bjhd,bjhe->bhde', kc * zeta[None, :, :, None], vc)
        return s, o

    s, o = lax.scan(step, s0.astype(jnp.float32), (to_chunks(q), to_chunks(k), to_chunks(v)))
    o = o.transpose(1, 0, 2, 3, 4).reshape(b, l, h, v.shape[-1])
    return o, s


def even_mixer(h, pos, s0, w_in, ln_g, ln_b, w_s, b_s, w_out):
    b, l, _ = h.shape
    z = h @ w_in
    u, v, q, k, vr, gate = jnp.split(z, EVEN_SPLITS, axis=-1)
    a_out, v_rows = sgu_mix(jax.nn.gelu(u), jax.nn.gelu(v), ln_g, ln_b, w_s, b_s)
    q = rotary(q.reshape(b, l, RET_HEADS, RET_DK), pos, RET_ROPE_BASE)
    k = rotary(k.reshape(b, l, RET_HEADS, RET_DK), pos, RET_ROPE_BASE) * (RET_DK ** -0.5)
    o, s = retention(q, k, vr.reshape(b, l, RET_HEADS, RET_DV), s0)
    o = o * lax.rsqrt(jnp.mean(o * o, axis=-1, keepdims=True) + EPS)
    b_out = (o.reshape(b, l, RET_HEADS * RET_DV) * jax.nn.silu(gate.astype(jnp.float32))).astype(h.dtype)
    y = jnp.concatenate([a_out, b_out], axis=-1) @ w_out
    return y, v_rows, s.astype(h.dtype)


def odd_qkv(h, pos, w_qkv, b_qkv):
    b, l, _ = h.shape
    q, k, v = jnp.split(h @ w_qkv + b_qkv, ODD_SPLITS, axis=-1)
    q = rotary(q.reshape(b, l, C_HEADS, C_HEAD_DIM), pos, C_ROPE_BASE)
    k = rotary(k.reshape(b, l, C_KV_HEADS, C_HEAD_DIM), pos, C_ROPE_BASE)
    return q, k, v.reshape(b, l, C_KV_HEADS, C_HEAD_DIM)


def sink_attention(q, k, v, valid, sinks):
    s = jnp.einsum('...qkgd,...skd->...kgqs', q, k).astype(jnp.float32) * (C_HEAD_DIM ** -0.5)
    s = jnp.where(valid, s, -jnp.inf)
    sink = jnp.broadcast_to(sinks.astype(jnp.float32).reshape(C_KV_HEADS, C_GROUP, 1, 1), s.shape[:-1] + (1,))
    p = jax.nn.softmax(jnp.concatenate([s, sink], axis=-1), axis=-1)[..., :-1]
    return jnp.einsum('...kgqs,...skd->...qkgd', p.astype(v.dtype), v)


def window_attn_prompt(q, k, v, sinks):
    b, l = q.shape[:2]
    nb = l // WINDOW
    qb = q.reshape(b, nb, WINDOW, C_KV_HEADS, C_GROUP, C_HEAD_DIM)

    def with_prev(t):
        tb = t.reshape(b, nb, WINDOW, C_KV_HEADS, C_HEAD_DIM)
        prev = jnp.concatenate([jnp.zeros_like(tb[:, :1]), tb[:, :-1]], axis=1)
        return jnp.concatenate([prev, tb], axis=2)

    qpos = jnp.arange(l, dtype=jnp.int32).reshape(nb, WINDOW)
    kpos = qpos[:, :1] - WINDOW + jnp.arange(2 * WINDOW, dtype=jnp.int32)[None, :]
    dist = qpos[:, :, None] - kpos[:, None, :]
    valid = (dist >= 0) & (dist < WINDOW) & (kpos[:, None, :] >= 0)
    o = sink_attention(qb, with_prev(k), with_prev(v), valid[:, None, None], sinks)
    return o.reshape(b, l, C_HEADS * C_HEAD_DIM)


def window_attn_sample(q, k, v, buf_k, buf_v, sinks):
    b, l = q.shape[:2]
    kk = jnp.concatenate([buf_k.astype(k.dtype), k], axis=1)
    vv = jnp.concatenate([buf_v.astype(v.dtype), v], axis=1)
    qpos = jnp.arange(l, dtype=jnp.int32)[:, None] + WINDOW
    kpos = jnp.arange(WINDOW + l, dtype=jnp.int32)[None, :]
    dist = qpos - kpos
    valid = (dist >= 0) & (dist < WINDOW)
    o = sink_attention(q.reshape(b, l, C_KV_HEADS, C_GROUP, C_HEAD_DIM), kk, vv, valid, sinks)
    return o.reshape(b, l, C_HEADS * C_HEAD_DIM), kk[:, -WINDOW:], vv[:, -WINDOW:]


def mem_kv(mem, g_mem, w_mk, w_mv):
    b = mem.shape[0]
    m = rms_norm(mem, g_mem)
    k = (m @ w_mk).reshape(b, N_MEM, MEM_HEADS, MEM_HEAD_DIM)
    v = (m @ w_mv).reshape(b, N_MEM, MEM_HEADS, MEM_HEAD_DIM)
    return k, v


def cross_attend(h, mk, mv, w_mq, w_mo):
    b, l, _ = h.shape
    q = (h @ w_mq).reshape(b, l, MEM_HEADS, MEM_HEAD_DIM)
    s = jnp.einsum('blhd,bmhd->bhlm', q, mk.astype(q.dtype)).astype(jnp.float32) * (MEM_HEAD_DIM ** -0.5)
    p = jax.nn.softmax(s, axis=-1)
    o = jnp.einsum('bhlm,bmhd->blhd', p.astype(q.dtype), mv.astype(q.dtype))
    return o.reshape(b, l, MEM_HEADS * MEM_HEAD_DIM) @ w_mo


def squared_relu_mlp(h, w_up, w_down):
    return jnp.square(jax.nn.relu(h @ w_up)) @ w_down


def _normal(k, shape, scale):
    return scale * jax.random.normal(k, shape, jnp.float32)


def _gain(k, shape):
    return 1.0 + _normal(k, shape, 0.02)


def setup_inputs(seed: int = 0) -> dict:
    key = jax.random.key(seed)
    ks = jax.random.split(key, 32)
    return {
        'x_prompt': _normal(ks[0], (BATCH, SEQ, D_MODEL), 1.0),
        'x_sample': _normal(ks[1], (DEC_BATCH, DEC_SEQ, D_MODEL), 1.0),
        'state_ret': _normal(ks[2], (N_EVEN, DEC_BATCH, RET_HEADS, RET_DK, RET_DV), 0.5),
        'cache_win_k': _normal(ks[3], (N_ODD, DEC_BATCH, WINDOW, C_KV_HEADS, C_HEAD_DIM), 1.0),
        'cache_win_v': _normal(ks[4], (N_ODD, DEC_BATCH, WINDOW, C_KV_HEADS, C_HEAD_DIM), 1.0),
        'cache_mem_k': _normal(ks[5], (DEPTH, DEC_BATCH, N_MEM, MEM_HEADS, MEM_HEAD_DIM), 1.0),
        'cache_mem_v': _normal(ks[6], (DEPTH, DEC_BATCH, N_MEM, MEM_HEADS, MEM_HEAD_DIM), 1.0),
        'mem_prompt': _normal(ks[7], (BATCH, N_MEM, D_MODEL), 1.0),
        'g_mix': _gain(ks[8], (DEPTH, D_MODEL)),
        'w_in_e': _normal(ks[9], (N_EVEN, D_MODEL, EVEN_IN), D_MODEL ** -0.5),
        'sgu_ln_g': _gain(ks[10], (N_EVEN, SGU_WIDTH)),
        'sgu_ln_b': _normal(ks[11], (N_EVEN, SGU_WIDTH), 0.02),
        'w_spatial': _normal(ks[12], (N_EVEN, SGU_GROUPS, SGU_CHUNK, SGU_CHUNK), SGU_CHUNK ** -0.5),
        'b_spatial': _gain(ks[13], (N_EVEN, SGU_GROUPS, SGU_CHUNK)),
        'w_out_e': _normal(ks[14], (N_EVEN, EVEN_OUT, D_MODEL), EVEN_OUT ** -0.5),
        'w_qkv_o': _normal(ks[15], (N_ODD, D_MODEL, ODD_IN), D_MODEL ** -0.5),
        'b_qkv_o': _normal(ks[16], (N_ODD, ODD_IN), 0.02),
        'sinks': _normal(ks[17], (N_ODD, C_HEADS), 0.5),
        'w_out_o': _normal(ks[18], (N_ODD, C_HEADS * C_HEAD_DIM, D_MODEL), (C_HEADS * C_HEAD_DIM) ** -0.5),
        'b_out_o': _normal(ks[19], (N_ODD, D_MODEL), 0.02),
        'g_cross': _gain(ks[20], (DEPTH, D_MODEL)),
        'g_mem': _gain(ks[21], (DEPTH, D_MODEL)),
        'w_mq': _normal(ks[22], (DEPTH, D_MODEL, MEM_HEADS * MEM_HEAD_DIM), D_MODEL ** -0.5),
        'w_mk': _normal(ks[23], (DEPTH, D_MODEL, MEM_HEADS * MEM_HEAD_DIM), D_MODEL ** -0.5),
        'w_mv': _normal(ks[24], (DEPTH, D_MODEL, MEM_HEADS * MEM_HEAD_DIM), D_MODEL ** -0.5),
        'w_mo': _normal(ks[25], (DEPTH, MEM_HEADS * MEM_HEAD_DIM, D_MODEL), (MEM_HEADS * MEM_HEAD_DIM) ** -0.5),
        'g_ffn': _gain(ks[26], (DEPTH, D_MODEL)),
        'w_up': _normal(ks[27], (DEPTH, D_MODEL, D_FF), D_MODEL ** -0.5),
        'w_down': _normal(ks[28], (DEPTH, D_FF, D_MODEL), D_FF ** -0.5),
        'g_final': _gain(ks[29], (D_MODEL,)),
    }


def reference(x_prompt, x_sample, state_ret, cache_win_k, cache_win_v, cache_mem_k, cache_mem_v,
              mem_prompt, g_mix, w_in_e, sgu_ln_g, sgu_ln_b, w_spatial, b_spatial, w_out_e,
              w_qkv_o, b_qkv_o, sinks, w_out_o, b_out_o, g_cross, g_mem, w_mq, w_mk, w_mv, w_mo,
              g_ffn, w_up, w_down, g_final):
    bp, lp, _ = x_prompt.shape
    ls = x_sample.shape[1]
    pos_p = jnp.arange(lp, dtype=jnp.int32)
    pos_s = PAST_LEN + jnp.arange(ls, dtype=jnp.int32)
    xp, xs = x_prompt, x_sample
    mem_k_p, mem_v_p = [], []
    ret_p, ret_s, sgu_v_s = [], [], []
    wk_p, wv_p, wk_s, wv_s = [], [], [], []
    for layer in range(DEPTH):
        j = layer // 2
        hp = rms_norm(xp, g_mix[layer])
        hs = rms_norm(xs, g_mix[layer])
        if layer % 2 == 0:
            s0 = jnp.zeros((bp, RET_HEADS, RET_DK, RET_DV), jnp.float32)
            op, _, sp = even_mixer(hp, pos_p, s0, w_in_e[j], sgu_ln_g[j], sgu_ln_b[j],
                                   w_spatial[j], b_spatial[j], w_out_e[j])
            o_s, v_rows, ss = even_mixer(hs, pos_s, state_ret[j], w_in_e[j], sgu_ln_g[j], sgu_ln_b[j],
                                         w_spatial[j], b_spatial[j], w_out_e[j])
            ret_p.append(sp)
            ret_s.append(ss)
            sgu_v_s.append(v_rows)
        else:
            qp, kp, vp = odd_qkv(hp, pos_p, w_qkv_o[j], b_qkv_o[j])
            op = window_attn_prompt(qp, kp, vp, sinks[j]) @ w_out_o[j] + b_out_o[j]
            qs, ks_, vs_ = odd_qkv(hs, pos_s, w_qkv_o[j], b_qkv_o[j])
            att_s, kbuf, vbuf = window_attn_sample(qs, ks_, vs_, cache_win_k[j], cache_win_v[j], sinks[j])
            o_s = att_s @ w_out_o[j] + b_out_o[j]
            wk_p.append(kp[:, -WINDOW:])
            wv_p.append(vp[:, -WINDOW:])
            wk_s.append(kbuf)
            wv_s.append(vbuf)
        xp = xp + op
        xs = xs + o_s
        mk, mv = mem_kv(mem_prompt, g_mem[layer], w_mk[layer], w_mv[layer])
        mem_k_p.append(mk)
        mem_v_p.append(mv)
        xp = xp + cross_attend(rms_norm(xp, g_cross[layer]), mk, mv, w_mq[layer], w_mo[layer])
        xs = xs + cross_attend(rms_norm(xs, g_cross[layer]), cache_mem_k[layer], cache_mem_v[layer],
                               w_mq[layer], w_mo[layer])
        xp = xp + squared_relu_mlp(rms_norm(xp, g_ffn[layer]), w_up[layer], w_down[layer])
        xs = xs + squared_relu_mlp(rms_norm(xs, g_ffn[layer]), w_up[layer], w_down[layer])
    y_prompt = rms_norm(xp, g_final)
    y_sample = rms_norm(xs, g_final)
    return (y_prompt, y_sample, jnp.stack(mem_k_p), jnp.stack(mem_v_p), jnp.stack(ret_p), jnp.stack(ret_s),
            jnp.stack(sgu_v_s), jnp.stack(wk_p), jnp.stack(wv_p), jnp.stack(wk_s), jnp.stack(wv_s))
```

```cpp
#include <hip/hip_runtime.h>
#include <hip/hip_cooperative_groups.h>
#include <cstdio>
#include <cstdint>
#include <cmath>
namespace cg = cooperative_groups;

#define LAS __attribute__((address_space(3)))
typedef unsigned short bf16_t;
typedef short bf16x8 __attribute__((ext_vector_type(8)));
typedef float f32x4 __attribute__((ext_vector_type(4)));
typedef float f32x2 __attribute__((ext_vector_type(2)));
typedef unsigned u32x4 __attribute__((ext_vector_type(4)));
typedef unsigned u32x2 __attribute__((ext_vector_type(2)));

#ifndef REP_PHASE
#define REP_PHASE 31
#define REP_COUNT 0
#define REP_SEL 0
#endif
#ifndef RUN_MASK
#define RUN_MASK 0x1fffff
#endif
#ifndef MK_ONE_LAUNCH
#define MK_ONE_LAUNCH 1
#endif

constexpr int DM = 1024, NP = 16384, NS = 1024, NTOK = NP + NS, SEQ = 2048;
constexpr int ZW = 5120, QKVW = 1536, FF = 4096;
constexpr float EPS = 1e-6f;
constexpr size_t MiB = 1u << 20;
constexpr size_t WS_CTL = 0, CTL_BYTES = 1 * MiB;
constexpr size_t WS_WIN = 1 * MiB, WS_WOUTE = 11 * MiB, WS_WQKV = 15 * MiB, WS_WOUTO = 18 * MiB, WS_WMQ = 20 * MiB, WS_WMKV = 24 * MiB, WS_WMO = 32 * MiB,
                 WS_WUP = 36 * MiB, WS_WDOWN = 52 * MiB, WS_ROTR = 68 * MiB, WS_ROTC = 70 * MiB, WS_RSS = 71 * MiB, WS_MN = 73 * MiB, WS_MKV = 81 * MiB,
                 WS_X = 97 * MiB, WS_XN = 165 * MiB, WS_Z = 199 * MiB, WS_AB = 369 * MiB, WS_Q = 437 * MiB, WS_ST = 471 * MiB, WS_END = 503 * MiB;
constexpr size_t O_Y = 0, O_MEMK = 17825792, O_MEMV = 22020096, O_RETP = 26214400, O_RETS = 27262976, O_SGUV = 44040192, O_WKP = 45088768, O_WVP = 45350912,
                 O_WKS = 45613056, O_WVS = 49807360;
constexpr int LDS_BYTES = 147456;
constexpr int SLOT_OFF = 147456 - 64;

__device__ __forceinline__ float bf2f(unsigned h) { return __uint_as_float(h << 16); }
typedef __bf16 bf16x2_t __attribute__((ext_vector_type(2)));
__device__ __forceinline__ unsigned cvt_pk_bf16(float lo, float hi) { const f32x2 v = {lo, hi}; const bf16x2_t b = __builtin_convertvector(v, bf16x2_t); return __builtin_bit_cast(unsigned, b); }
__device__ __forceinline__ float wave_sum(float v) {
#pragma unroll
    for (int o = 1; o < 64; o <<= 1) v += __shfl_xor(v, o);
    return v;
}
__device__ __forceinline__ float fexp2(float x) { return __builtin_amdgcn_exp2f(x); }
__device__ __forceinline__ float fexp(float x) { return __builtin_amdgcn_exp2f(x * 1.4426950408889634f); }
__device__ __forceinline__ float gelu_tanh(float x) { const float x2 = x * x; const float t = x * (-2.3022081f - 0.10294324f * x2); return x * __builtin_amdgcn_rcpf(1.0f + __builtin_amdgcn_exp2f(t)); }
__device__ __forceinline__ float silu(float x) { return x * __builtin_amdgcn_rcpf(1.0f + __builtin_amdgcn_exp2f(-1.4426950408889634f * x)); }
__device__ __forceinline__ u32x4 pack8(f32x4 a, f32x4 b) { u32x4 w; w.x = cvt_pk_bf16(a[0], a[1]); w.y = cvt_pk_bf16(a[2], a[3]); w.z = cvt_pk_bf16(b[0], b[1]); w.w = cvt_pk_bf16(b[2], b[3]); return w; }
__device__ __forceinline__ float rss_scale(const float* rss, int row) {
    const f32x4* p = (const f32x4*)(rss + (size_t)row * 16);
    const f32x4 a = p[0], b = p[1], c = p[2], d = p[3];
    const float s = ((a[0] + a[1]) + (a[2] + a[3])) + ((b[0] + b[1]) + (b[2] + b[3])) + ((c[0] + c[1]) + (c[2] + c[3])) + ((d[0] + d[1]) + (d[2] + d[3]));
    return __builtin_amdgcn_rsqf(s * (1.0f / 1024.0f) + EPS);
}
#define MFMA16(y, x, acc) __builtin_amdgcn_mfma_f32_16x16x32_bf16((y), (x), (acc), 0, 0, 0)
__device__ __forceinline__ bf16x8 frag(const LAS unsigned char* base, int row, int pitchB, int kbyte) { return *(const LAS bf16x8*)(base + row * pitchB + kbyte); }

namespace pg8 {
#define PG8_LAS __attribute__((address_space(3)))
constexpr int BM = 256, BK = 64, HALF = 128, HTB = HALF * BK * 2, STAGE_BYTES = 8 * HTB, NXCD = 8, WGM = 8;
__host__ __device__ __forceinline__ int lds_byte(int r, int c) { const int st = (r >> 4) * 2 + (c >> 5), rr = r & 15, cc = c & 31, ob = rr * 64 + cc * 2; return st * 1024 + (ob ^ (((ob >> 9) & 1) << 5)); }
__host__ __device__ __forceinline__ void stage_rc(int b, int& R, int& C) { const int st = b / 1024, sb = b % 1024, swz = sb ^ (((sb >> 9) & 1) << 5); R = (st >> 1) * 16 + swz / 64; C = (st & 1) * 32 + (swz % 64) / 2; }
__host__ __device__ __forceinline__ int perm32(int rho) { const int n = rho >> 4, i = rho & 15; return 8 * (i >> 2) + 4 * n + (i & 3); }
struct Unit { int pm, pn; };
struct Gemm { const bf16_t* A; const bf16_t* Bt; int M, N, K; };
struct StaticOrder {
    int nM, nN, nwg, G, c;
    __host__ __device__ void init(int M, int N, int G_, int c_) { nM = M / BM; nN = N / BM; nwg = nM * nN; G = G_; c = c_; }
    __host__ __device__ bool next(int i, Unit& u) const {
        const long L = (long)i * G + c; if (L >= nwg) return false;
        int wgid = (int)L; { const int q = nwg / NXCD, r = nwg % NXCD, xcd = wgid % NXCD, off = wgid / NXCD; wgid = (xcd < r ? xcd * (q + 1) : r * (q + 1) + (xcd - r) * q) + off; }
        const int nig = WGM * nN, gid = wgid / nig, fm = gid * WGM, gsz = (nM - fm) < WGM ? (nM - fm) : WGM;
        u.pm = fm + ((wgid % nig) % gsz); u.pn = (wgid % nig) / gsz; return true;
    }
    __device__ __forceinline__ void a_ready(const Unit&) const {}
    __device__ __forceinline__ void done(const Unit&) const {}
};

template <class Epi, class Sched, bool ALIGN_EPI = false, bool SP2 = false>
__device__ __forceinline__ void gemm_phase(PG8_LAS unsigned char* lds, const Gemm g, const Sched& S, const Epi& E, const int tid) {
    const int wid = __builtin_amdgcn_readfirstlane(tid >> 6), lane = tid & 63, wr = wid >> 2, wc = wid & 3, fr = lane & 15, fq = lane >> 4;
    const int K = g.K, nt = K / BK;
    unsigned voffA[2], voffB[2];
#pragma unroll
    for (int i = 0; i < 2; ++i) { int R, C; stage_rc(tid * 16 + i * 8192, R, C); const int Rb = Epi::PERM ? ((R & ~31) + perm32(R & 31)) : R;
        voffA[i] = (unsigned)(R * K + C) * 2u; voffB[i] = (unsigned)(Rb * K + C) * 2u; }
    const size_t kstep = (size_t)(BK * 2);
    const size_t hstep = (size_t)HALF * K * 2;
    const size_t tstep = 2 * hstep;
    const unsigned ldsw = (unsigned)wid * 1024u;
    const int aoff = lds_byte(wr * 64 + fr, fq * 8), boff = lds_byte(wc * 32 + fr, fq * 8);
#define PG8_SA(b, h) (((b) * 2 + (h)) * HTB)
#define PG8_SB(b, h) ((4 + (b) * 2 + (h)) * HTB)
#define PG8_STAGE(bufoff, gbase, voff) do { _Pragma("unroll") for (int _i = 0; _i < 2; ++_i) \
        __builtin_amdgcn_global_load_lds((const unsigned*)((const char*)(gbase) + (voff)[_i]), (PG8_LAS unsigned*)(lds + (bufoff) + ldsw + _i * 8192), 16, 0, 0); } while (0)
#define PG8_LDA(dst, b, h) do { _Pragma("unroll") for (int m = 0; m < 4; ++m) _Pragma("unroll") for (int k = 0; k < 2; ++k) dst[m][k] = *(const PG8_LAS bf16x8*)(lds + PG8_SA(b, h) + aoff + m * 2048 + k * 1024); } while (0)
#define PG8_LDB(dst, b, h) do { _Pragma("unroll") for (int n = 0; n < 2; ++n) _Pragma("unroll") for (int k = 0; k < 2; ++k) dst[n][k] = *(const PG8_LAS bf16x8*)(lds + PG8_SB(b, h) + boff + n * 2048 + k * 1024); } while (0)
#define PG8_MMA(ai, bj, At, Bt) do { __builtin_amdgcn_s_setprio(1); _Pragma("unroll") for (int m = 0; m < 4; ++m) _Pragma("unroll") for (int n = 0; n < 2; ++n) _Pragma("unroll") for (int k = 0; k < 2; ++k) \
        acc[ai][bj][m][n] = __builtin_amdgcn_mfma_f32_16x16x32_bf16(Bt[n][k], At[m][k], acc[ai][bj][m][n], 0, 0, 0); __builtin_amdgcn_s_setprio(0); } while (0)
#define PG8_WAIT_V(n) asm volatile("s_waitcnt vmcnt(" #n ")" ::: "memory")
#define PG8_WAIT_L(n) asm volatile("s_waitcnt lgkmcnt(" #n ")" ::: "memory")
#define PG8_BAR __builtin_amdgcn_s_barrier()
#define PG8_SCHED __builtin_amdgcn_sched_barrier(0)
    Unit cur, nxt; int ui = 0;
    if (!S.next(0, cur)) return;
    f32x4 acc[2][2][4][2];
#pragma unroll
    for (int a = 0; a < 2; ++a)
#pragma unroll
        for (int b = 0; b < 2; ++b)
#pragma unroll
            for (int m = 0; m < 4; ++m)
#pragma unroll
                for (int n = 0; n < 2; ++n) acc[a][b][m][n] = (f32x4){0.f, 0.f, 0.f, 0.f};
    bf16x8 At[4][2], B0[2][2], B1[2][2];
    const char* cA = (const char*)g.A + (size_t)cur.pm * tstep; const char* cB = (const char*)g.Bt + (size_t)cur.pn * tstep;
    S.a_ready(cur);
    if constexpr (SP2) {
        PG8_STAGE(PG8_SB(0, 0), cB, voffB); PG8_STAGE(PG8_SB(0, 1), cB + hstep, voffB); PG8_STAGE(PG8_SA(0, 0), cA, voffA); PG8_STAGE(PG8_SA(0, 1), cA + hstep, voffA);
        if (wr == 1) PG8_BAR;
        PG8_WAIT_V(2); PG8_BAR;
        PG8_STAGE(PG8_SB(1, 0), cB + kstep, voffB); PG8_STAGE(PG8_SA(1, 0), cA + kstep, voffA); PG8_STAGE(PG8_SB(1, 1), cB + hstep + kstep, voffB);
        PG8_WAIT_V(6); PG8_BAR;
    } else {
        PG8_STAGE(PG8_SB(0, 0), cB, voffB); PG8_STAGE(PG8_SA(0, 0), cA, voffA); PG8_STAGE(PG8_SB(0, 1), cB + hstep, voffB); PG8_STAGE(PG8_SA(0, 1), cA + hstep, voffA);
        if (wr == 1) PG8_BAR;
        PG8_WAIT_V(4); PG8_BAR;
        PG8_STAGE(PG8_SB(1, 0), cB + kstep, voffB); PG8_STAGE(PG8_SA(1, 0), cA + kstep, voffA); PG8_STAGE(PG8_SB(1, 1), cB + hstep + kstep, voffB);
        PG8_WAIT_V(6); PG8_BAR;
    }
    for (;;) {
        const bool has_next = S.next(ui + 1, nxt);
        const char* nA = has_next ? (const char*)g.A + (size_t)nxt.pm * tstep : cA; const char* nB = has_next ? (const char*)g.Bt + (size_t)nxt.pn * tstep : cB;
        for (int t = 0; t < nt; t += 2) {
            const bool last = (t == nt - 2);
            const char* a1 = cA + (size_t)(t + 1) * kstep;
            const char* a2 = last ? nA : cA + (size_t)(t + 2) * kstep; const char* b2 = last ? nB : cB + (size_t)(t + 2) * kstep;
            const char* a3 = a2 + kstep; const char* b3 = b2 + kstep;
            if (last && has_next) S.a_ready(nxt);
            if constexpr (SP2) {
            PG8_LDB(B0, 0, 0); PG8_LDB(B1, 0, 1); PG8_SCHED; PG8_LDA(At, 0, 0); PG8_STAGE(PG8_SA(1, 1), a1 + hstep, voffA);
            PG8_WAIT_V(8); PG8_WAIT_L(0); PG8_BAR; PG8_MMA(0, 0, At, B0); PG8_MMA(0, 1, At, B1); PG8_BAR; PG8_SCHED;
            PG8_LDA(At, 0, 1); PG8_STAGE(PG8_SB(0, 0), b2, voffB); PG8_STAGE(PG8_SB(0, 1), b2 + hstep, voffB); PG8_STAGE(PG8_SA(0, 0), a2, voffA);
            PG8_WAIT_V(8); PG8_WAIT_L(0); PG8_BAR; PG8_MMA(1, 0, At, B0); PG8_MMA(1, 1, At, B1); PG8_BAR; PG8_SCHED;
            PG8_LDB(B0, 1, 0); PG8_LDB(B1, 1, 1); PG8_SCHED; PG8_LDA(At, 1, 0); PG8_STAGE(PG8_SA(0, 1), a2 + hstep, voffA);
            PG8_WAIT_V(8); PG8_WAIT_L(0); PG8_BAR; PG8_MMA(0, 0, At, B0); PG8_MMA(0, 1, At, B1); PG8_BAR; PG8_SCHED;
            PG8_LDA(At, 1, 1); PG8_STAGE(PG8_SB(1, 0), b3, voffB); PG8_STAGE(PG8_SB(1, 1), b3 + hstep, voffB); PG8_STAGE(PG8_SA(1, 0), a3, voffA);
            PG8_WAIT_V(8); PG8_WAIT_L(0); PG8_BAR; PG8_MMA(1, 0, At, B0); PG8_MMA(1, 1, At, B1); PG8_BAR; PG8_SCHED;
            } else {
            PG8_LDB(B0, 0, 0); PG8_SCHED; PG8_LDA(At, 0, 0); PG8_STAGE(PG8_SA(1, 1), a1 + hstep, voffA);
            PG8_WAIT_L(8); PG8_BAR; PG8_WAIT_L(0); PG8_MMA(0, 0, At, B0); PG8_BAR; PG8_SCHED;
            PG8_LDB(B1, 0, 1); PG8_STAGE(PG8_SB(0, 0), b2, voffB);
            PG8_BAR; PG8_WAIT_L(0); PG8_MMA(0, 1, At, B1); PG8_BAR;
            PG8_LDA(At, 0, 1); PG8_STAGE(PG8_SA(0, 0), a2, voffA);
            PG8_BAR; PG8_WAIT_L(0); PG8_MMA(1, 0, At, B0); PG8_BAR; PG8_SCHED;
            PG8_STAGE(PG8_SB(0, 1), b2 + hstep, voffB);
            PG8_WAIT_V(6); PG8_BAR; PG8_MMA(1, 1, At, B1); PG8_BAR;
            PG8_LDB(B0, 1, 0); PG8_SCHED; PG8_LDA(At, 1, 0); PG8_STAGE(PG8_SA(0, 1), a2 + hstep, voffA);
            PG8_WAIT_L(8); PG8_BAR; PG8_WAIT_L(0); PG8_MMA(0, 0, At, B0); PG8_BAR; PG8_SCHED;
            PG8_LDB(B1, 1, 1); PG8_STAGE(PG8_SB(1, 0), b3, voffB);
            PG8_BAR; PG8_WAIT_L(0); PG8_MMA(0, 1, At, B1); PG8_BAR;
            PG8_LDA(At, 1, 1); PG8_STAGE(PG8_SA(1, 0), a3, voffA);
            PG8_BAR; PG8_WAIT_L(0); PG8_MMA(1, 0, At, B0); PG8_BAR; PG8_SCHED;
            PG8_STAGE(PG8_SB(1, 1), b3 + hstep, voffB);
            PG8_WAIT_V(6); PG8_BAR; PG8_MMA(1, 1, At, B1); PG8_BAR;
            }
        }
        if constexpr (ALIGN_EPI) { if (wr == 0) PG8_BAR; }
        E(acc, cur, wr, wc, fr, fq); S.done(cur);
        if (!has_next) break;
#pragma unroll
        for (int a = 0; a < 2; ++a)
#pragma unroll
            for (int b = 0; b < 2; ++b)
#pragma unroll
                for (int m = 0; m < 4; ++m)
#pragma unroll
                    for (int n = 0; n < 2; ++n) acc[a][b][m][n] = (f32x4){0.f, 0.f, 0.f, 0.f};
        cur = nxt; cA = nA; cB = nB; ++ui;
        if constexpr (ALIGN_EPI) { if (wr == 1) PG8_BAR; }
    }
    PG8_WAIT_V(0);
    if constexpr (!ALIGN_EPI) { if (wr == 0) PG8_BAR; }
    PG8_BAR;
#undef PG8_SA
#undef PG8_SB
#undef PG8_STAGE
#undef PG8_LDA
#undef PG8_LDB
#undef PG8_MMA
#undef PG8_WAIT_V
#undef PG8_WAIT_L
#undef PG8_BAR
#undef PG8_SCHED
}

struct EpiAct {
    static constexpr bool PERM = true;
    bf16_t* O; int ldc; const float* rss; const float* bias; float scale; int act; int act_cols;
    __device__ __forceinline__ void operator()(const f32x4 (&acc)[2][2][4][2], const Unit& u, int wr, int wc, int fr, int fq) const {
        const int row0 = u.pm * BM + wr * 64 + fr, col0 = u.pn * BM + wc * 32 + 8 * fq;
        f32x4 bv[2][2];
#pragma unroll
        for (int bj = 0; bj < 2; ++bj)
#pragma unroll
            for (int n = 0; n < 2; ++n) bv[bj][n] = bias ? *(const f32x4*)(bias + col0 + bj * HALF + 4 * n) : (f32x4){0.f, 0.f, 0.f, 0.f};
        const bool do_gelu = (act == 1) && (u.pn * BM < act_cols);
#pragma unroll
        for (int ai = 0; ai < 2; ++ai)
#pragma unroll
            for (int m = 0; m < 4; ++m) {
                const int row = row0 + ai * HALF + m * 16;
                const float sc = rss ? rss_scale(rss, row) * scale : scale;
                bf16_t* rowp = O + (size_t)row * ldc + col0;
#pragma unroll
                for (int bj = 0; bj < 2; ++bj) {
                    f32x4 v0 = acc[ai][bj][m][0] * sc + bv[bj][0], v1 = acc[ai][bj][m][1] * sc + bv[bj][1];
                    if (do_gelu) {
#pragma unroll
                        for (int e = 0; e < 4; ++e) { v0[e] = gelu_tanh(v0[e]); v1[e] = gelu_tanh(v1[e]); }
                    } else if (act == 2) {
#pragma unroll
                        for (int e = 0; e < 4; ++e) { const float a = fmaxf(v0[e], 0.f), b = fmaxf(v1[e], 0.f); v0[e] = a * a; v1[e] = b * b; }
                    }
                    *(u32x4*)(rowp + bj * HALF) = pack8(v0, v1);
                }
            }
    }
};
__device__ __forceinline__ void unpack8(u32x4 w, f32x4& a, f32x4& b) { a = (f32x4){bf2f(w.x & 0xffffu), bf2f(w.x >> 16), bf2f(w.y & 0xffffu), bf2f(w.y >> 16)}; b = (f32x4){bf2f(w.z & 0xffffu), bf2f(w.z >> 16), bf2f(w.w & 0xffffu), bf2f(w.w >> 16)}; }
struct EpiRes {
    static constexpr bool PERM = true;
    const float* xa; const float* xb; int split_row; bf16_t* XB; const float* bias; float* rss;
    __device__ __forceinline__ void operator()(const f32x4 (&acc)[2][2][4][2], const Unit& u, int wr, int wc, int fr, int fq) const {
        const int row0 = u.pm * BM + wr * 64 + fr, col0 = u.pn * BM + wc * 32 + 8 * fq;
        f32x4 bv[2][2];
#pragma unroll
        for (int bj = 0; bj < 2; ++bj)
#pragma unroll
            for (int n = 0; n < 2; ++n) bv[bj][n] = bias ? *(const f32x4*)(bias + col0 + bj * HALF + 4 * n) : (f32x4){0.f, 0.f, 0.f, 0.f};
#pragma unroll
        for (int ai = 0; ai < 2; ++ai)
#pragma unroll
            for (int m = 0; m < 4; ++m) {
                const int row = row0 + ai * HALF + m * 16;
                float ss = 0.f;
#pragma unroll
                for (int bj = 0; bj < 2; ++bj) {
                    const int c = col0 + bj * HALF;
                    f32x4 o0, o1;
                    if (xa) { const float* src = (row < split_row) ? xa + (size_t)row * DM : xb + (size_t)(row - split_row) * DM; o0 = *(const f32x4*)(src + c); o1 = *(const f32x4*)(src + c + 4); }
                    else unpack8(*(const u32x4*)(XB + (size_t)row * DM + c), o0, o1);
                    const f32x4 v0 = acc[ai][bj][m][0] + bv[bj][0] + o0, v1 = acc[ai][bj][m][1] + bv[bj][1] + o1;
                    ss += (v0[0] * v0[0] + v0[1] * v0[1]) + (v0[2] * v0[2] + v0[3] * v0[3]) + (v1[0] * v1[0] + v1[1] * v1[1]) + (v1[2] * v1[2] + v1[3] * v1[3]);
                    *(u32x4*)(XB + (size_t)row * DM + c) = pack8(v0, v1);
                }
                ss += __shfl_xor(ss, 16); ss += __shfl_xor(ss, 32);
                if (fq == 0) rss[(size_t)row * 16 + u.pn * 4 + wc] = ss;
            }
    }
};
struct EpiMem {
    static constexpr bool PERM = true;
    float* outK; float* outV; bf16_t* MKV;
    __device__ __forceinline__ void operator()(const f32x4 (&acc)[2][2][4][2], const Unit& u, int wr, int wc, int fr, int fq) const {
        const int row0 = u.pm * BM + wr * 64 + fr, col0 = u.pn * BM + wc * 32 + 8 * fq;
        float* ob = (col0 >= 1024) ? outV : outK;
#pragma unroll
        for (int ai = 0; ai < 2; ++ai)
#pragma unroll
            for (int m = 0; m < 4; ++m) {
                const int row = row0 + ai * HALF + m * 16;
#pragma unroll
                for (int bj = 0; bj < 2; ++bj) {
                    const int c = col0 + bj * HALF;
                    const f32x4 v0 = acc[ai][bj][m][0], v1 = acc[ai][bj][m][1];
                    float* op = ob + (size_t)row * 1024 + (c & 1023);
                    __builtin_nontemporal_store(v0, (f32x4*)op); __builtin_nontemporal_store(v1, (f32x4*)(op + 4));
                    *(u32x4*)(MKV + (size_t)row * 2048 + c) = pack8(v0, v1);
                }
            }
    }
};
}

struct RowAct {
    bf16_t* O; int ldc; const float* rss; const float* bias; float scale; int act; int act_cols;
    __device__ __forceinline__ void operator()(int row, int col, f32x4 v0, f32x4 v1, int tid) const {
        const float sc = rss ? rss_scale(rss, row) * scale : scale;
        f32x4 b0 = (f32x4){0.f, 0.f, 0.f, 0.f}, b1 = b0; if (bias) { b0 = *(const f32x4*)(bias + col); b1 = *(const f32x4*)(bias + col + 4); }
        v0 = v0 * sc + b0; v1 = v1 * sc + b1;
        if (act == 1 && col < act_cols) {
#pragma unroll
            for (int e = 0; e < 4; ++e) { v0[e] = gelu_tanh(v0[e]); v1[e] = gelu_tanh(v1[e]); }
        } else if (act == 2) {
#pragma unroll
            for (int e = 0; e < 4; ++e) { const float a = fmaxf(v0[e], 0.f), b = fmaxf(v1[e], 0.f); v0[e] = a * a; v1[e] = b * b; }
        }
        *(u32x4*)(O + (size_t)row * ldc + col) = pack8(v0, v1);
    }
};
struct RowRes {
    const float* xa; const float* xb; int split_row; bf16_t* XB; const float* bias; float* rss;
    __device__ __forceinline__ void operator()(int row, int col, f32x4 v0, f32x4 v1, int tid) const {
        f32x4 b0 = (f32x4){0.f, 0.f, 0.f, 0.f}, b1 = b0; if (bias) { b0 = *(const f32x4*)(bias + col); b1 = *(const f32x4*)(bias + col + 4); }
        f32x4 o0, o1;
        if (xa) { const float* src = (row < split_row) ? xa + (size_t)row * DM : xb + (size_t)(row - split_row) * DM; o0 = *(const f32x4*)(src + col); o1 = *(const f32x4*)(src + col + 4); }
        else pg8::unpack8(*(const u32x4*)(XB + (size_t)row * DM + col), o0, o1);
        v0 = v0 + b0 + o0; v1 = v1 + b1 + o1;
        *(u32x4*)(XB + (size_t)row * DM + col) = pack8(v0, v1);
        float ss = (v0[0] * v0[0] + v0[1] * v0[1]) + (v0[2] * v0[2] + v0[3] * v0[3]) + (v1[0] * v1[0] + v1[1] * v1[1]) + (v1[2] * v1[2] + v1[3] * v1[3]);
        ss += __shfl_xor(ss, 1); ss += __shfl_xor(ss, 2); ss += __shfl_xor(ss, 4);
        if ((tid & 7) == 0) rss[(size_t)row * 16 + (col >> 6)] = ss;
    }
};
template <class RowEpi> __device__ __forceinline__ void gemm_small(LAS unsigned char* L, const bf16_t* A, const bf16_t* Bt, int N, int K, const RowEpi& E, int tid, int lane, int wave) {
    const int l15 = lane & 15, lq = lane >> 4;
    const int nblk = 16 * (N >> 6), kslice = K >> 3, nks = kslice >> 5;
    for (int blk = blockIdx.x; blk < nblk; blk += gridDim.x) {
        const int row0 = (blk & 15) * 64, col0 = (blk >> 4) * 64;
        f32x4 acc[4][4];
#pragma unroll
        for (int x = 0; x < 4; ++x)
#pragma unroll
            for (int y = 0; y < 4; ++y) acc[x][y] = (f32x4){0.f, 0.f, 0.f, 0.f};
        const bf16_t* ap = A + (size_t)(row0 + l15) * K + wave * kslice + 8 * lq;
        const bf16_t* bp = Bt + (size_t)(col0 + l15) * K + wave * kslice + 8 * lq;
#pragma unroll 4
        for (int ks = 0; ks < nks; ++ks) {
            bf16x8 xf[4], yf[4];
#pragma unroll
            for (int x = 0; x < 4; ++x) xf[x] = *(const bf16x8*)(ap + (size_t)(16 * x) * K + ks * 32);
#pragma unroll
            for (int y = 0; y < 4; ++y) yf[y] = *(const bf16x8*)(bp + (size_t)(16 * y) * K + ks * 32);
#pragma unroll
            for (int x = 0; x < 4; ++x)
#pragma unroll
                for (int y = 0; y < 4; ++y) acc[x][y] = MFMA16(yf[y], xf[x], acc[x][y]);
        }
        __syncthreads();
        LAS float* red = (LAS float*)L + wave * 4352;
#pragma unroll
        for (int x = 0; x < 4; ++x)
#pragma unroll
            for (int y = 0; y < 4; ++y) *(LAS f32x4*)(red + (16 * x + l15) * 68 + 16 * y + 4 * lq) = acc[x][y];
        __syncthreads();
        const int r = tid >> 3, c8 = (tid & 7) * 8;
        f32x4 v0 = (f32x4){0.f, 0.f, 0.f, 0.f}, v1 = v0;
#pragma unroll
        for (int w = 0; w < 8; ++w) { const LAS float* q = (const LAS float*)L + w * 4352 + r * 68 + c8; v0 += *(const LAS f32x4*)q; v1 += *(const LAS f32x4*)(q + 4); }
        E(NP + row0 + r, col0 + c8, v0, v1, tid);
    }
    __syncthreads();
}

struct Params {
    const float* in[30];
    float* out;
    unsigned char* ws;
    float inv[96];
    int ph_lo, ph_hi, pmask, pad;
};

template <class T> __device__ __forceinline__ T* opq(T* p) { asm volatile("" : "+s"(p)); return p; }

struct SrcBf16 { const bf16_t* p; size_t pitch;
    __device__ __forceinline__ u32x4 operator()(int r, int cq) const { return *(const u32x4*)(p + (size_t)r * pitch + cq * 8); } };
struct SrcBf16Z { const bf16_t* p; size_t pitch; int zero_below;
    __device__ __forceinline__ u32x4 operator()(int r, int cq) const { if (r < zero_below) return (u32x4){0u, 0u, 0u, 0u}; return *(const u32x4*)(p + (size_t)r * pitch + cq * 8); } };
struct SrcF32 { const float* p; size_t pitch;
    __device__ __forceinline__ u32x4 operator()(int r, int cq) const { const f32x4* q = (const f32x4*)(p + (size_t)r * pitch + cq * 8); return pack8(q[0], q[1]); } };
struct SrcBf16Scaled { const bf16_t* p; size_t pitch; float lg2; int top;
    __device__ __forceinline__ u32x4 operator()(int r, int cq) const {
        const u32x4 v = *(const u32x4*)(p + (size_t)r * pitch + cq * 8); const float s = fexp2((float)(top - r) * lg2); u32x4 w;
#pragma unroll
        for (int e = 0; e < 4; ++e) w[e] = cvt_pk_bf16(bf2f(v[e] & 0xffffu) * s, bf2f(v[e] >> 16) * s);
        return w; } };
struct SrcTail { const bf16_t* n;
    __device__ __forceinline__ u32x4 operator()(int r, int cq) const { u32x4 v = (u32x4){0u, 0u, 0u, 0u}; if (r < 8) v = *(const u32x4*)(n + (size_t)r * QKVW + cq * 8); return v; } };

template <int R, int C, class Src> __device__ __forceinline__ void stage_n(LAS unsigned char* dst, int pitchB, const Src& S, int tid, int roff = 0) {
    constexpr int CQ = C / 8, N = R * CQ;
#pragma unroll
    for (int it0 = 0; it0 < N; it0 += 512) { const int it = it0 + tid;
        if ((N % 512 == 0) || it < N) { const int r = it / CQ, cq = it % CQ; *(LAS u32x4*)(dst + (r + roff) * pitchB + cq * 16) = S(r, cq); } }
}
template <int R, int C, class Src> __device__ __forceinline__ void stage_t(LAS unsigned char* dst, int pitchB, const Src& S, int tid, int roff = 0) {
    constexpr int RP = R / 2, CQ = C / 8, N = RP * CQ;
#pragma unroll
    for (int it0 = 0; it0 < N; it0 += 512) { const int it = it0 + tid;
        if ((N % 512 == 0) || it < N) { const int rp = it % RP, cq = it / RP; const u32x4 a = S(2 * rp, cq), b = S(2 * rp + 1, cq);
            LAS unsigned char* d = dst + (cq * 8) * pitchB + rp * 4 + roff * 2;
#pragma unroll
            for (int e = 0; e < 4; ++e) {
                *(LAS unsigned*)(d + (2 * e) * pitchB) = (a[e] & 0xffffu) | (b[e] << 16);
                *(LAS unsigned*)(d + (2 * e + 1) * pitchB) = (a[e] >> 16) | (b[e] & 0xffff0000u); } } }
}

__device__ __forceinline__ int next_item(unsigned* ctr, LAS unsigned char* L) {
    __syncthreads();
    if (threadIdx.x == 0) *(LAS int*)(L + SLOT_OFF) = (int)__hip_atomic_fetch_add(ctr, 1u, __ATOMIC_RELAXED, __HIP_MEMORY_SCOPE_AGENT);
    __syncthreads();
    return *(LAS int*)(L + SLOT_OFF);
}

#define XB_TMO      128
#define XB_XCNT(j)  (256  + 64 * (j))
#define XB_XSUB(j)  (1280 + 64 * (j))
#define XB_XGEN(j)  (2304 + 64 * (j))
#define XB_TOP      3328
#define XB_TOPGEN   3392
#define XCD_BAR_WORDS 3456
#define XB_SPIN_CAP (1u << 18)
__device__ __forceinline__ unsigned xb_ld(unsigned* p)              { return __hip_atomic_load(p, __ATOMIC_RELAXED, __HIP_MEMORY_SCOPE_AGENT); }
__device__ __forceinline__ unsigned xb_add(unsigned* p, unsigned v) { return __hip_atomic_fetch_add(p, v, __ATOMIC_RELAXED, __HIP_MEMORY_SCOPE_AGENT); }
__device__ __forceinline__ unsigned xb_xcc_id() { return (unsigned)__builtin_amdgcn_s_getreg((3 << 11) | 20) & 0xFu; }
#define XB_SPIN(cond, bar) do { unsigned _sp = 0; while (cond) { __builtin_amdgcn_s_sleep(1); \
    if ((++_sp & 255u) == 0u) { if (xb_ld(&(bar)[XB_TMO])) break; if (_sp > XB_SPIN_CAP) { atomicAdd(&(bar)[XB_TMO], 1u); break; } } } } while (0)
struct XcdBarrier { unsigned* bar; unsigned x; volatile LAS unsigned* st; };
__device__ __forceinline__ XcdBarrier xcd_barrier_post(unsigned* bar, volatile LAS unsigned* st) {
    XcdBarrier b; b.bar = bar; b.x = xb_xcc_id(); b.st = st;
    if (threadIdx.x == 0) (void)xb_add(&bar[XB_XCNT(b.x)], 1u);
    return b;
}
__device__ __forceinline__ void xcd_barrier_complete(unsigned* bar, unsigned x, unsigned& nloc, unsigned& nx) {
    const unsigned G = gridDim.x * gridDim.y * gridDim.z;
    unsigned sum, cnt, mine, sp = 0u;
    for (;;) {
        sum = 0u; cnt = 0u; mine = 0u;
#pragma unroll
        for (unsigned j = 0; j < 16; ++j) { const unsigned c = xb_ld(&bar[XB_XCNT(j)]); sum += c; cnt += (c > 0u) ? 1u : 0u; mine = (j == x) ? c : mine; }
        if (sum == G) break;
        __builtin_amdgcn_s_sleep(1);
        if ((++sp & 255u) == 0u) { if (xb_ld(&bar[XB_TMO])) break; if (sp > XB_SPIN_CAP) { atomicAdd(&bar[XB_TMO], 1u); break; } }
    }
    nloc = mine > 0u ? mine : 1u; nx = cnt > 0u ? cnt : 1u;
}
__device__ __forceinline__ void xcd_barrier(const XcdBarrier& b) {
    asm volatile("s_waitcnt vmcnt(0)" ::: "memory");
    __syncthreads();
    if (threadIdx.x == 0) {
        unsigned* bar = b.bar;
        __builtin_amdgcn_s_waitcnt(0);
        unsigned nloc = b.st[0], nx = b.st[1];
        if (nloc == 0u) { xcd_barrier_complete(bar, b.x, nloc, nx); b.st[0] = nloc; b.st[1] = nx; }
        const unsigned old = xb_add(&bar[XB_XSUB(b.x)], 1u);
        const unsigned gen = old / nloc;
        if (old + 1u == (gen + 1u) * nloc) {
            __builtin_amdgcn_fence(__ATOMIC_RELEASE, "agent");
            asm volatile("s_waitcnt vmcnt(0)" ::: "memory");
            const unsigned og = xb_add(&bar[XB_TOP], 1u);
            const unsigned tg = og / nx;
            if (og + 1u == (tg + 1u) * nx) xb_add(&bar[XB_TOPGEN], 1u);
            else XB_SPIN(xb_ld(&bar[XB_TOPGEN]) == tg, bar);
            __builtin_amdgcn_fence(__ATOMIC_ACQUIRE, "agent");
            xb_add(&bar[XB_XGEN(b.x)], 1u);
            asm volatile("s_waitcnt vmcnt(0)" ::: "memory");
        } else {
            XB_SPIN(xb_ld(&bar[XB_XGEN(b.x)]) == gen, bar);
            __builtin_amdgcn_fence(__ATOMIC_ACQUIRE, "agent");
            asm volatile("s_waitcnt vmcnt(0)" ::: "memory");
        }
    }
    __syncthreads();
}

__device__ __forceinline__ void p0_transpose_item(const float* W, int K, int N, bf16_t* WT, int row_off, LAS float* scr, int item, int lane, const float* gk) {
    const int nblk = N / 32, kb = item / nblk, nb = item % nblk, k0 = 64 * kb, n0 = 32 * nb;
    float wv[32];
#pragma unroll
    for (int i = 0; i < 32; ++i) { const int kk = 2 * i + (lane >> 5); wv[i] = __builtin_nontemporal_load(W + (size_t)(k0 + kk) * N + n0 + (lane & 31)); }
    if (gk) {
#pragma unroll
        for (int i = 0; i < 32; ++i) wv[i] *= gk[k0 + 2 * i + (lane >> 5)]; }
#pragma unroll
    for (int i = 0; i < 32; ++i) { const int kk = 2 * i + (lane >> 5); scr[kk * 33 + (lane & 31)] = wv[i]; }
    asm volatile("s_waitcnt lgkmcnt(0)" ::: "memory");
    const int c = lane & 7;
#pragma unroll
    for (int j = 0; j < 4; ++j) { const int n = (lane >> 3) + 8 * j; const LAS float* s = scr + (8 * c) * 33 + n;
        u32x4 o; o.x = cvt_pk_bf16(s[0 * 33], s[1 * 33]); o.y = cvt_pk_bf16(s[2 * 33], s[3 * 33]); o.z = cvt_pk_bf16(s[4 * 33], s[5 * 33]); o.w = cvt_pk_bf16(s[6 * 33], s[7 * 33]);
        *(u32x4*)(WT + (size_t)(row_off + n0 + n) * K + k0 + 8 * c) = o; }
    asm volatile("s_waitcnt lgkmcnt(0)" ::: "memory");
}

__device__ __forceinline__ void phase_prologue(const Params& P, LAS unsigned char* L, int tid, int lane, int wave) {
    unsigned char* ws = opq(P.ws);
    LAS float* scr = (LAS float*)(L + wave * 16384);
    const int gw = blockIdx.x * 8 + wave, NGW = gridDim.x * 8;
    constexpr int I_IN = 16 * 160, I_OE = 32 * 32, I_QKV = 16 * 48, I_SQ = 16 * 32, I_UP = 16 * 128, I_DN = 64 * 32;
    constexpr int NITEMS = I_IN + I_OE + I_QKV + I_SQ + 8 * I_SQ + 2 * I_UP + 2 * I_DN;
    for (int it = gw; it < NITEMS; it += NGW) {
        int r = it; const float* src; bf16_t* dst; int K = 1024, N = 1024, roff = 0; const float* gk = nullptr;
        if (r < I_IN) { src = P.in[9]; N = 5120; dst = (bf16_t*)(ws + WS_WIN); gk = P.in[8]; }
        else if ((r -= I_IN) < I_OE) { src = P.in[14]; K = 2048; dst = (bf16_t*)(ws + WS_WOUTE); }
        else if ((r -= I_OE) < I_QKV) { src = P.in[15]; N = 1536; dst = (bf16_t*)(ws + WS_WQKV); gk = P.in[8] + DM; }
        else if ((r -= I_QKV) < I_SQ) { src = P.in[18]; dst = (bf16_t*)(ws + WS_WOUTO); }
        else if ((r -= I_SQ) < 8 * I_SQ) { const int w = r / I_SQ, l = w & 1, kind = w >> 1; r -= w * I_SQ;
            src = P.in[22 + kind] + (size_t)l * 1024 * 1024; roff = (kind == 2) ? 1024 : 0; if (kind == 0) gk = P.in[20] + l * DM;
            dst = (kind == 0) ? (bf16_t*)(ws + WS_WMQ + l * 2 * MiB) : (kind == 3) ? (bf16_t*)(ws + WS_WMO + l * 2 * MiB) : (bf16_t*)(ws + WS_WMKV + l * 4 * MiB); }
        else if ((r -= 8 * I_SQ) < 2 * I_UP) { const int l = r / I_UP; r -= l * I_UP; src = P.in[27] + (size_t)l * 1024 * 4096; N = 4096; dst = (bf16_t*)(ws + WS_WUP + l * 8 * MiB); gk = P.in[26] + l * DM; }
        else { r -= 2 * I_UP; const int l = r / I_DN; r -= l * I_DN; src = P.in[28] + (size_t)l * 1024 * 4096; K = 4096; dst = (bf16_t*)(ws + WS_WDOWN + l * 8 * MiB); }
        p0_transpose_item(src, K, N, dst, roff, scr, r, lane, gk);
    }
    {
        bf16_t* XN = (bf16_t*)(ws + WS_XN); float* rss = (float*)(ws + WS_RSS);
        for (int row = gw; row < NTOK; row += NGW) {
            const float* xr = (row < NP) ? P.in[0] + (size_t)row * DM : P.in[1] + (size_t)(row - NP) * DM;
            float ss = 0.f;
#pragma unroll
            for (int j = 0; j < 2; ++j) { const int c = 8 * lane + 512 * j;
                const f32x4 a = *(const f32x4*)(xr + c), b = *(const f32x4*)(xr + c + 4);
                ss += (a[0] * a[0] + a[1] * a[1]) + (a[2] * a[2] + a[3] * a[3]) + (b[0] * b[0] + b[1] * b[1]) + (b[2] * b[2] + b[3] * b[3]);
                *(u32x4*)(XN + (size_t)row * DM + c) = pack8(a, b); }
            ss = wave_sum(ss);
            if (lane < 16) rss[(size_t)row * 16 + lane] = (lane == 0) ? ss : 0.f;
        }
    }
    {
        const float* mem = P.in[7]; const float* g = P.in[21];
        for (int row = gw; row < 2048; row += NGW) {
            const float* xr = mem + (size_t)row * DM; f32x4 v[4]; float ss = 0.f;
#pragma unroll
            for (int j = 0; j < 2; ++j) { const int c = 8 * lane + 512 * j; v[2 * j] = *(const f32x4*)(xr + c); v[2 * j + 1] = *(const f32x4*)(xr + c + 4);
                const f32x4 a = v[2 * j], b = v[2 * j + 1];
                ss += (a[0] * a[0] + a[1] * a[1]) + (a[2] * a[2] + a[3] * a[3]) + (b[0] * b[0] + b[1] * b[1]) + (b[2] * b[2] + b[3] * b[3]); }
            const float r = 1.0f / sqrtf(wave_sum(ss) * (1.0f / 1024.0f) + EPS);
#pragma unroll
            for (int l = 0; l < 2; ++l) { bf16_t* MN = (bf16_t*)(ws + WS_MN + l * 4 * MiB);
#pragma unroll
                for (int j = 0; j < 2; ++j) { const int c = 8 * lane + 512 * j; const f32x4 ga = *(const f32x4*)(g + l * DM + c), gb = *(const f32x4*)(g + l * DM + c + 4);
                    *(u32x4*)(MN + (size_t)row * DM + c) = pack8(v[2 * j] * r * ga, v[2 * j + 1] * r * gb); } }
        }
    }
    {
        f32x2* rotR = (f32x2*)(ws + WS_ROTR); f32x2* rotC = (f32x2*)(ws + WS_ROTC);
        const int gt = blockIdx.x * 512 + tid, NGT = gridDim.x * 512;
        for (int i = gt; i < 2056 * 96; i += NGT) {
            const int pi = i / 96, j = i % 96; const int pos = pi < 2048 ? pi : 16384 + pi - 2048;
            const float inv = P.inv[j];
            const float ang = (float)pos * inv;
            double rev = (double)ang * 0.15915494309189535; rev -= rint(rev);
            const float c = __builtin_amdgcn_cosf((float)rev), s = __builtin_amdgcn_sinf((float)rev);
            if (j < 64) rotR[pi * 64 + j] = (f32x2){c, s}; else rotC[pi * 32 + (j - 64)] = (f32x2){c, s};
        }
    }
}

__device__ __forceinline__ void phase_rowpass_a(const Params& P, int lane, int wave) {
    unsigned char* ws = opq(P.ws); bf16_t* Z = (bf16_t*)(ws + WS_Z); const f32x2* rotR = (const f32x2*)(ws + WS_ROTR);
    const float* lng = P.in[10]; const float* lnb = P.in[11]; float* sguv = opq(P.out) + O_SGUV;
    const int gw = blockIdx.x * 8 + wave, NGW = gridDim.x * 8;
    for (int row = gw; row < NTOK; row += NGW) {
        bf16_t* zr = Z + (size_t)row * ZW;
        float v[16]; float s = 0.f;
#pragma unroll
        for (int j = 0; j < 2; ++j) { const u32x4 w = *(const u32x4*)(zr + 1024 + 8 * lane + 512 * j);
#pragma unroll
            for (int e = 0; e < 4; ++e) { v[8 * j + 2 * e] = bf2f(w[e] & 0xffffu); v[8 * j + 2 * e + 1] = bf2f(w[e] >> 16); } }
#pragma unroll
        for (int e = 0; e < 16; ++e) s += v[e];
        const float mean = wave_sum(s) * (1.0f / 1024.0f); float q = 0.f;
#pragma unroll
        for (int e = 0; e < 16; ++e) { v[e] -= mean; q += v[e] * v[e]; }
        const float rstd = 1.0f / sqrtf(wave_sum(q) * (1.0f / 1024.0f) + EPS);
#pragma unroll
        for (int j = 0; j < 2; ++j) { const int c = 8 * lane + 512 * j;
            const f32x4 ga = *(const f32x4*)(lng + c), gb = *(const f32x4*)(lng + c + 4), ba = *(const f32x4*)(lnb + c), bb = *(const f32x4*)(lnb + c + 4);
            f32x4 a, b;
#pragma unroll
            for (int e = 0; e < 4; ++e) { a[e] = v[8 * j + e] * rstd * ga[e] + ba[e]; b[e] = v[8 * j + 4 + e] * rstd * gb[e] + bb[e]; }
            *(u32x4*)(zr + 1024 + c) = pack8(a, b);
            if (row >= NP) { float* o = sguv + (size_t)(row - NP) * 1024 + c; *(f32x4*)o = a; *(f32x4*)(o + 4) = b; } }
        const int pi = row < NP ? (row & 2047) : 2048 + ((row - NP) & 7);
        const f32x2 cs = rotR[pi * 64 + lane];
#pragma unroll
        for (int hh = 0; hh < 8; ++hh) { bf16_t* p = zr + 2048 + hh * 128 + lane; const float a = bf2f(p[0]), b = bf2f(p[64]); const float sc = hh >= 4 ? 0.08838834764831845f : 1.0f;
            const float ra = (a * cs.x - b * cs.y) * sc, rb = (a * cs.y + b * cs.x) * sc; const unsigned w = cvt_pk_bf16(ra, rb); p[0] = (bf16_t)(w & 0xffffu); p[64] = (bf16_t)(w >> 16); }
    }
}

__device__ __forceinline__ void phase_rowpass_b(const Params& P, int lane, int wave) {
    unsigned char* ws = opq(P.ws); bf16_t* QKV = (bf16_t*)(ws + WS_Z); const f32x2* rotC = (const f32x2*)(ws + WS_ROTC);
    float* wkp = opq(P.out) + O_WKP; float* wvp = opq(P.out) + O_WVP;
    const int gw = blockIdx.x * 8 + wave, NGW = gridDim.x * 8;
    for (int row = gw; row < NTOK; row += NGW) {
        bf16_t* zr = QKV + (size_t)row * QKVW;
        const int pi = row < NP ? (row & 2047) : 2048 + ((row - NP) & 7);
        const bool tail = (row < NP) && ((row & 2047) >= 1920);
        const int b = row >> 11, w = (row & 2047) - 1920;
#pragma unroll
        for (int pass = 0; pass < 2; ++pass) { const int task = lane + 64 * pass;
            if (task < 80) { const int hd = task >> 2, j0 = (task & 3) * 8;
                bf16_t* p = zr + hd * 64 + j0; const u32x4 va = *(const u32x4*)p, vb = *(const u32x4*)(p + 32);
                const f32x4* cs = (const f32x4*)(rotC + pi * 32 + j0);
                f32x4 ra0, ra1, rb0, rb1; u32x4 oa, ob;
#pragma unroll
                for (int e = 0; e < 4; ++e) { const f32x4 c2 = cs[e];
                    const float a0 = bf2f(va[e] & 0xffffu), a1 = bf2f(va[e] >> 16), b0 = bf2f(vb[e] & 0xffffu), b1 = bf2f(vb[e] >> 16);
                    const float xa0 = a0 * c2[0] - b0 * c2[1], xb0 = a0 * c2[1] + b0 * c2[0], xa1 = a1 * c2[2] - b1 * c2[3], xb1 = a1 * c2[3] + b1 * c2[2];
                    oa[e] = cvt_pk_bf16(xa0, xa1); ob[e] = cvt_pk_bf16(xb0, xb1);
                    if (e < 2) { ra0[2 * e] = xa0; ra0[2 * e + 1] = xa1; rb0[2 * e] = xb0; rb0[2 * e + 1] = xb1; } else { ra1[2 * e - 4] = xa0; ra1[2 * e - 3] = xa1; rb1[2 * e - 4] = xb0; rb1[2 * e - 3] = xb1; } }
                *(u32x4*)p = oa; *(u32x4*)(p + 32) = ob;
                if (tail && hd >= 16) { float* o = wkp + ((size_t)(b * 128 + w) * 4 + (hd - 16)) * 64 + j0; *(f32x4*)o = ra0; *(f32x4*)(o + 4) = ra1; *(f32x4*)(o + 32) = rb0; *(f32x4*)(o + 36) = rb1; } } }
        if (tail) { const u32x2 v = *(const u32x2*)(zr + 1280 + 4 * lane);
            *(f32x4*)(wvp + (size_t)(b * 128 + w) * 256 + 4 * lane) = (f32x4){bf2f(v.x & 0xffffu), bf2f(v.x >> 16), bf2f(v.y & 0xffffu), bf2f(v.y >> 16)}; }
    }
}

__device__ __forceinline__ void unit_scan(const Params& P, LAS unsigned char* L, int item, int tid, int lane, int wave) {
    unsigned char* ws = opq(P.ws); const bf16_t* Z = (const bf16_t*)(ws + WS_Z); bf16_t* ST = (bf16_t*)(ws + WS_ST); float* retp = opq(P.out) + O_RETP;
    const int es = item & 3, h = (item >> 2) & 3, b = item >> 4;
    const int l15 = lane & 15, lq = lane >> 4;
    LAS unsigned char* KT = L; LAS unsigned char* VT = L + 34816;
    const float lg2 = log2f(1.0f - fexp2(-5.0f - (float)h)); const float cd = fexp2(128.0f * lg2);
    f32x4 acc[4];
#pragma unroll
    for (int x = 0; x < 4; ++x) acc[x] = (f32x4){0.f, 0.f, 0.f, 0.f};
    for (int c = 0; c < 16; ++c) {
        const size_t row0 = (size_t)b * SEQ + c * 128;
        bf16_t* st = ST + ((size_t)((b * 16 + c) * 4 + h)) * 32768;
#pragma unroll
        for (int x = 0; x < 4; ++x) { const int e = es * 64 + 16 * x + l15, d = 16 * wave + 4 * lq; u32x2 w; w.x = cvt_pk_bf16(acc[x][0], acc[x][1]); w.y = cvt_pk_bf16(acc[x][2], acc[x][3]); *(u32x2*)(st + e * 128 + d) = w; }
        __syncthreads();
        stage_t<128, 128>(KT, 272, SrcBf16Scaled{Z + row0 * ZW + 2560 + h * 128, (size_t)ZW, lg2, 127}, tid);
        stage_t<128, 64>(VT, 272, SrcBf16{Z + row0 * ZW + 3072 + h * 256 + es * 64, (size_t)ZW}, tid);
        __syncthreads();
#pragma unroll
        for (int x = 0; x < 4; ++x) acc[x] = acc[x] * cd;
#pragma unroll
        for (int ks = 0; ks < 4; ++ks) { const int kb = (ks * 32 + 8 * lq) * 2; const bf16x8 yf = frag(KT, 16 * wave + l15, 272, kb);
#pragma unroll
            for (int x = 0; x < 4; ++x) acc[x] = MFMA16(yf, frag(VT, 16 * x + l15, 272, kb), acc[x]); }
    }
#pragma unroll
    for (int x = 0; x < 4; ++x) { const int e = es * 64 + 16 * x + l15;
#pragma unroll
        for (int r = 0; r < 4; ++r) { const int d = 16 * wave + 4 * lq + r; retp[((size_t)(b * 4 + h) * 128 + d) * 256 + e] = acc[x][r]; } }
}

__device__ __forceinline__ void unit_sgu(const Params& P, LAS unsigned char* L, int item, int tid, int lane, int wave) {
    unsigned char* ws = opq(P.ws); const bf16_t* Z = (const bf16_t*)(ws + WS_Z); bf16_t* AB = (bf16_t*)(ws + WS_AB);
    const int g = item & 3, c = (item >> 2) & 15, b = item >> 6;
    const int l15 = lane & 15, lq = lane >> 4;
    const size_t row0 = (size_t)b * SEQ + c * 128;
    LAS unsigned char* WL = L; LAS unsigned char* VT = L + 34816;
    const float* wsp = P.in[12] + (size_t)g * 128 * 128;
#pragma unroll
    for (int k = 0; k < 4; ++k) { const int it = tid + 512 * k, t = it >> 4, sq = it & 15; const f32x4* q = (const f32x4*)(wsp + t * 128 + sq * 8); f32x4 a = q[0], bb = q[1];
#pragma unroll
        for (int e = 0; e < 4; ++e) { if (sq * 8 + e > t) a[e] = 0.f; if (sq * 8 + 4 + e > t) bb[e] = 0.f; }
        *(LAS u32x4*)(WL + t * 272 + sq * 16) = pack8(a, bb); }
    stage_t<128, 256>(VT, 272, SrcBf16{Z + row0 * ZW + 1024 + g * 256, (size_t)ZW}, tid);
    __syncthreads();
    f32x4 acc[8][2];
#pragma unroll
    for (int x = 0; x < 8; ++x) { acc[x][0] = (f32x4){0.f, 0.f, 0.f, 0.f}; acc[x][1] = (f32x4){0.f, 0.f, 0.f, 0.f}; }
#pragma unroll
    for (int ks = 0; ks < 4; ++ks) { const int kb = (ks * 32 + 8 * lq) * 2;
        const bf16x8 y0 = frag(VT, 32 * wave + l15, 272, kb), y1 = frag(VT, 32 * wave + 16 + l15, 272, kb);
#pragma unroll
        for (int x = 0; x < 8; ++x) if (ks * 32 <= x * 16 + 15) { const bf16x8 xf = frag(WL, 16 * x + l15, 272, kb); acc[x][0] = MFMA16(y0, xf, acc[x][0]); acc[x][1] = MFMA16(y1, xf, acc[x][1]); } }
    const float* bsp = P.in[13] + g * 128;
#pragma unroll
    for (int x = 0; x < 8; ++x) { const int t = 16 * x + l15; const float bs = bsp[t];
#pragma unroll
        for (int n = 0; n < 2; ++n) { const int d = 32 * wave + 16 * n + 4 * lq;
            const u32x2 u = *(const u32x2*)(Z + (row0 + t) * ZW + g * 256 + d);
            u32x2 w; w.x = cvt_pk_bf16(bf2f(u.x & 0xffffu) * (acc[x][n][0] + bs), bf2f(u.x >> 16) * (acc[x][n][1] + bs));
            w.y = cvt_pk_bf16(bf2f(u.y & 0xffffu) * (acc[x][n][2] + bs), bf2f(u.y >> 16) * (acc[x][n][3] + bs));
            *(u32x2*)(AB + (row0 + t) * 2048 + g * 256 + d) = w; } }
}

__device__ __forceinline__ void unit_sgu_sample(const Params& P, int bs, int tid) {
    unsigned char* ws = opq(P.ws); const bf16_t* Z = (const bf16_t*)(ws + WS_Z); bf16_t* AB = (bf16_t*)(ws + WS_AB);
    const size_t row0 = (size_t)NP + bs * 8; const int col = 2 * tid, g = col >> 8;
    const float* wsp = P.in[12] + (size_t)g * 128 * 128; const float* bsp = P.in[13] + g * 128;
    float v0[8], v1[8];
#pragma unroll
    for (int s = 0; s < 8; ++s) { const unsigned w = *(const unsigned*)(Z + (row0 + s) * ZW + 1024 + col); v0[s] = bf2f(w & 0xffffu); v1[s] = bf2f(w >> 16); }
#pragma unroll
    for (int t = 0; t < 8; ++t) { float m0 = bsp[t], m1 = m0;
#pragma unroll
        for (int s = 0; s <= t; ++s) { const float w = wsp[t * 128 + s]; m0 += w * v0[s]; m1 += w * v1[s]; }
        const unsigned u = *(const unsigned*)(Z + (row0 + t) * ZW + col);
        *(unsigned*)(AB + (row0 + t) * 2048 + col) = cvt_pk_bf16(bf2f(u & 0xffffu) * m0, bf2f(u >> 16) * m1); }
}

__device__ __forceinline__ void unit_ret_sample(const Params& P, LAS unsigned char* L, int item, int tid, int lane, int wave) {
    unsigned char* ws = opq(P.ws); const bf16_t* Z = (const bf16_t*)(ws + WS_Z); bf16_t* AB = (bf16_t*)(ws + WS_AB);
    asm volatile("" : "+v"(tid));
    const int h = item & 3, bs = item >> 2; const size_t row0 = (size_t)NP + bs * 8;
    const float lg2 = log2f(1.0f - fexp2(-5.0f - (float)h)); const float cd = fexp2(8.0f * lg2);
    LAS float* qs = (LAS float*)L;
    LAS float* kz = (LAS float*)(L + 4096);
    LAS float* kr = (LAS float*)(L + 8192);
    LAS float* sc = (LAS float*)(L + 12288);
    LAS float* po = (LAS float*)(L + 12544);
    LAS float* red = (LAS float*)(L + 12544 + 65536);
    for (int it = tid; it < 2048; it += 512) { const int qk = it >> 10, r = (it >> 7) & 7, d = it & 127;
        const float v = bf2f(Z[(row0 + r) * ZW + 2048 + qk * 512 + h * 128 + d]);
        if (qk == 0) qs[d * 8 + r] = v; else { kr[r * 128 + d] = v; kz[d * 8 + r] = v * fexp2((float)(7 - r) * lg2); } }
    __syncthreads();
    if (tid < 64) { const int i = tid >> 3, j = tid & 7; float s = 0.f;
        if (j <= i) { for (int d = 0; d < 128; ++d) s += qs[d * 8 + i] * kr[j * 128 + d]; s *= fexp2((float)(i - j) * lg2); }
        sc[i * 8 + j] = s; }
    const int e = tid & 255, dh = tid >> 8;
    float vj[8];
#pragma unroll
    for (int j = 0; j < 8; ++j) vj[j] = bf2f(Z[(row0 + j) * ZW + 3072 + h * 256 + e]);
    {
        const int e4 = (tid & 63) * 4, ds = tid >> 6;
        f32x4 vj4[8];
#pragma unroll
        for (int j = 0; j < 8; ++j) { const u32x2 w = *(const u32x2*)(Z + (row0 + j) * ZW + 3072 + h * 256 + e4); vj4[j] = (f32x4){bf2f(w.x & 0xffffu), bf2f(w.x >> 16), bf2f(w.y & 0xffffu), bf2f(w.y >> 16)}; }
        const float* S0 = P.in[2] + ((size_t)(bs * 4 + h) * 128 + ds * 16) * 256 + e4; float* S1 = opq(P.out) + O_RETS + ((size_t)(bs * 4 + h) * 128 + ds * 16) * 256 + e4;
        f32x4 pacc[8];
#pragma unroll
        for (int i = 0; i < 8; ++i) pacc[i] = (f32x4){0.f, 0.f, 0.f, 0.f};
#pragma unroll 4
        for (int dd = 0; dd < 16; ++dd) { const int d = ds * 16 + dd; const f32x4 sv = *(const f32x4*)(S0 + (size_t)dd * 256);
            const f32x4 q0 = *(const LAS f32x4*)(qs + d * 8), q1 = *(const LAS f32x4*)(qs + d * 8 + 4), k0 = *(const LAS f32x4*)(kz + d * 8), k1 = *(const LAS f32x4*)(kz + d * 8 + 4);
            f32x4 sn = sv * cd;
#pragma unroll
            for (int i = 0; i < 4; ++i) { pacc[i] += sv * q0[i]; pacc[4 + i] += sv * q1[i]; sn += vj4[i] * k0[i] + vj4[4 + i] * k1[i]; }
            __builtin_nontemporal_store(sn, (f32x4*)(S1 + (size_t)dd * 256)); }
#pragma unroll
        for (int i = 0; i < 8; ++i) *(LAS f32x4*)(po + (ds * 8 + i) * 256 + e4) = pacc[i];
    }
    __syncthreads();
    float o[4]; float ssq[4];
#pragma unroll
    for (int ii = 0; ii < 4; ++ii) { const int i = dh * 4 + ii; float a = 0.f;
#pragma unroll
        for (int ds = 0; ds < 8; ++ds) a += po[(ds * 8 + i) * 256 + e];
        a *= fexp2((float)(i + 1) * lg2);
#pragma unroll
        for (int j = 0; j < 8; ++j) if (j <= i) a += sc[i * 8 + j] * vj[j];
        o[ii] = a; ssq[ii] = wave_sum(a * a); }
    if (lane == 0) {
#pragma unroll
        for (int ii = 0; ii < 4; ++ii) red[wave * 4 + ii] = ssq[ii]; }
    __syncthreads();
#pragma unroll
    for (int ii = 0; ii < 4; ++ii) { const int i = dh * 4 + ii; const int w0 = dh * 4;
        const float tot = (red[(w0 + 0) * 4 + ii] + red[(w0 + 1) * 4 + ii]) + (red[(w0 + 2) * 4 + ii] + red[(w0 + 3) * 4 + ii]);
        const float rstd = 1.0f / sqrtf(tot * (1.0f / 256.0f) + EPS);
        const float gate = bf2f(Z[(row0 + i) * ZW + 4096 + h * 256 + e]);
        AB[(row0 + i) * 2048 + 1024 + h * 256 + e] = (bf16_t)(cvt_pk_bf16(o[ii] * rstd * silu(gate), 0.f) & 0xffffu); }
}

__device__ __forceinline__ void unit_ret_out(const Params& P, LAS unsigned char* L, int item, int tid, int lane, int wave) {
    unsigned char* ws = opq(P.ws); const bf16_t* Z = (const bf16_t*)(ws + WS_Z); bf16_t* AB = (bf16_t*)(ws + WS_AB); const bf16_t* ST = (const bf16_t*)(ws + WS_ST);
    const int h = item & 3, c = (item >> 2) & 15, b = item >> 6;
    const int l15 = lane & 15, lq = lane >> 4;
    const size_t row0 = (size_t)b * SEQ + c * 128;
    const float lg2 = log2f(1.0f - fexp2(-5.0f - (float)h));
    LAS unsigned char* QL = L; LAS unsigned char* KL = L + 34816; LAS unsigned char* VT = L + 69632; LAS float* RED = (LAS float*)(L + 139264);
    stage_n<128, 128>(QL, 272, SrcBf16{Z + row0 * ZW + 2048 + h * 128, (size_t)ZW}, tid);
    stage_n<128, 128>(KL, 272, SrcBf16{Z + row0 * ZW + 2560 + h * 128, (size_t)ZW}, tid);
    stage_t<128, 256>(VT, 272, SrcBf16{Z + row0 * ZW + 3072 + h * 256, (size_t)ZW}, tid);
    __syncthreads();
    {
        f32x4 sc[8];
#pragma unroll
        for (int x = 0; x < 8; ++x) sc[x] = (f32x4){0.f, 0.f, 0.f, 0.f};
#pragma unroll
        for (int ks = 0; ks < 4; ++ks) { const int kb = (ks * 32 + 8 * lq) * 2; const bf16x8 yf = frag(KL, 16 * wave + l15, 272, kb);
#pragma unroll
            for (int x = 0; x < 8; ++x) sc[x] = MFMA16(yf, frag(QL, 16 * x + l15, 272, kb), sc[x]); }
        __syncthreads();
#pragma unroll
        for (int x = 0; x < 8; ++x) { const int i = 16 * x + l15, j0 = 16 * wave + 4 * lq; float p[4];
#pragma unroll
            for (int r = 0; r < 4; ++r) { const int j = j0 + r; p[r] = (i >= j) ? sc[x][r] * fexp2((float)(i - j) * lg2) : 0.f; }
            u32x2 w; w.x = cvt_pk_bf16(p[0], p[1]); w.y = cvt_pk_bf16(p[2], p[3]); *(LAS u32x2*)(KL + i * 272 + j0 * 2) = w; }
    }
    f32x4 acc[8][2];
#pragma unroll
    for (int x = 0; x < 8; ++x) { acc[x][0] = (f32x4){0.f, 0.f, 0.f, 0.f}; acc[x][1] = (f32x4){0.f, 0.f, 0.f, 0.f}; }
    {
        const bf16_t* st = ST + ((size_t)((b * 16 + c) * 4 + h)) * 32768;
        bf16x8 yg[4][2];
#pragma unroll
        for (int ks = 0; ks < 4; ++ks) { yg[ks][0] = *(const bf16x8*)(st + (32 * wave + l15) * 128 + ks * 32 + 8 * lq); yg[ks][1] = *(const bf16x8*)(st + (32 * wave + 16 + l15) * 128 + ks * 32 + 8 * lq); }
#pragma unroll
        for (int ks = 0; ks < 4; ++ks) { const int kb = (ks * 32 + 8 * lq) * 2;
#pragma unroll
            for (int x = 0; x < 8; ++x) { const bf16x8 xf = frag(QL, 16 * x + l15, 272, kb); acc[x][0] = MFMA16(yg[ks][0], xf, acc[x][0]); acc[x][1] = MFMA16(yg[ks][1], xf, acc[x][1]); } }
#pragma unroll
        for (int x = 0; x < 8; ++x) { const float xi = fexp2((float)(16 * x + l15 + 1) * lg2); acc[x][0] = acc[x][0] * xi; acc[x][1] = acc[x][1] * xi; }
    }
    __syncthreads();
#pragma unroll
    for (int ks = 0; ks < 4; ++ks) { const int kb = (ks * 32 + 8 * lq) * 2;
        const bf16x8 y0 = frag(VT, 32 * wave + l15, 272, kb), y1 = frag(VT, 32 * wave + 16 + l15, 272, kb);
#pragma unroll
        for (int x = 0; x < 8; ++x) if (ks * 32 <= x * 16 + 15) { const bf16x8 xf = frag(KL, 16 * x + l15, 272, kb); acc[x][0] = MFMA16(y0, xf, acc[x][0]); acc[x][1] = MFMA16(y1, xf, acc[x][1]); } }
#pragma unroll
    for (int x = 0; x < 8; ++x) { float ss = 0.f;
#pragma unroll
        for (int n = 0; n < 2; ++n)
#pragma unroll
            for (int r = 0; r < 4; ++r) ss += acc[x][n][r] * acc[x][n][r];
        ss += __shfl_xor(ss, 16); ss += __shfl_xor(ss, 32);
        if (lq == 0) RED[wave * 128 + 16 * x + l15] = ss; }
    __syncthreads();
#pragma unroll
    for (int x = 0; x < 8; ++x) { const int i = 16 * x + l15; float tot = 0.f;
#pragma unroll
        for (int w = 0; w < 8; ++w) tot += RED[w * 128 + i];
        const float rstd = 1.0f / sqrtf(tot * (1.0f / 256.0f) + EPS);
#pragma unroll
        for (int n = 0; n < 2; ++n) { const int e = 32 * wave + 16 * n + 4 * lq;
            const u32x2 gt = *(const u32x2*)(Z + (row0 + i) * ZW + 4096 + h * 256 + e);
            u32x2 w; w.x = cvt_pk_bf16(acc[x][n][0] * rstd * silu(bf2f(gt.x & 0xffffu)), acc[x][n][1] * rstd * silu(bf2f(gt.x >> 16)));
            w.y = cvt_pk_bf16(acc[x][n][2] * rstd * silu(bf2f(gt.y & 0xffffu)), acc[x][n][3] * rstd * silu(bf2f(gt.y >> 16)));
            *(u32x2*)(AB + (row0 + i) * 2048 + 1024 + h * 256 + e) = w; } }
}

template <int NKT> __device__ __forceinline__ float softmax_rows(f32x4 (&sc)[NKT], LAS unsigned char* PL, int l15, int lq, float extra) {
    float m = extra;
#pragma unroll
    for (int y = 0; y < NKT; ++y) m = fmaxf(m, fmaxf(fmaxf(sc[y][0], sc[y][1]), fmaxf(sc[y][2], sc[y][3])));
    m = fmaxf(m, __shfl_xor(m, 16)); m = fmaxf(m, __shfl_xor(m, 32));
    float s = 0.f;
#pragma unroll
    for (int y = 0; y < NKT; ++y) { float p[4];
#pragma unroll
        for (int r = 0; r < 4; ++r) { p[r] = fexp(sc[y][r] - m); s += p[r]; }
        u32x2 w; w.x = cvt_pk_bf16(p[0], p[1]); w.y = cvt_pk_bf16(p[2], p[3]); *(LAS u32x2*)(PL + l15 * 528 + (16 * y + 4 * lq) * 2) = w; }
    s += __shfl_xor(s, 16); s += __shfl_xor(s, 32);
    s += fexp(extra - m);
    return 1.0f / s;
}

template <bool SAMPLE> __device__ __forceinline__ void unit_cross(const Params& P, LAS unsigned char* L, int layer, int item, int tid, int lane, int wave) {
    unsigned char* ws = opq(P.ws); const bf16_t* Q = (const bf16_t*)(ws + WS_Q); bf16_t* O = (bf16_t*)(ws + WS_AB);
    const int l15 = lane & 15, lq = lane >> 4;
    int h, tok; bool active, store_ok;
    const bf16_t* kvb = nullptr; const float* kf = nullptr; const float* vf = nullptr;
    if (SAMPLE) { h = item & 3; const int bs = item >> 2; tok = NP + bs * 8 + (l15 & 7); active = (wave == 0); store_ok = l15 < 8;
        kf = P.in[5] + ((size_t)(layer * 128 + bs) * 256) * 1024 + h * 256; vf = P.in[6] + ((size_t)(layer * 128 + bs) * 256) * 1024 + h * 256; }
    else { h = item & 3; const int rt = (item >> 2) & 15, b = item >> 6; tok = b * SEQ + rt * 128 + 16 * wave + l15; active = true; store_ok = true;
        kvb = (const bf16_t*)(ws + WS_MKV + layer * 8 * MiB) + (size_t)(b * 256) * 2048 + h * 256; }
    LAS unsigned char* KL = L; LAS unsigned char* PL = L + 69632 + wave * 8448;
    f32x4 sc[16];
#pragma unroll
    for (int y = 0; y < 16; ++y) sc[y] = (f32x4){0.f, 0.f, 0.f, 0.f};
    bf16x8 qf[8];
#pragma unroll
    for (int k = 0; k < 8; ++k) qf[k] = *(const bf16x8*)(Q + (size_t)tok * DM + h * 256 + k * 32 + 8 * lq);
#pragma unroll
    for (int dh = 0; dh < 2; ++dh) {
        if (SAMPLE) stage_n<256, 128>(KL, 272, SrcF32{kf + dh * 128, (size_t)1024}, tid); else stage_n<256, 128>(KL, 272, SrcBf16{kvb + dh * 128, (size_t)2048}, tid);
        __syncthreads();
        if (active) {
#pragma unroll
            for (int ks = 0; ks < 4; ++ks) { const int kb = (ks * 32 + 8 * lq) * 2;
#pragma unroll
                for (int y = 0; y < 16; ++y) { sc[y] = MFMA16(frag(KL, 16 * y + l15, 272, kb), qf[dh * 4 + ks], sc[y]); if ((y & 3) == 3) __builtin_amdgcn_sched_barrier(0); } } }
        __syncthreads();
    }
    float inv = 0.f;
    if (active) inv = softmax_rows<16>(sc, PL, l15, lq, -INFINITY);
#pragma unroll 1
    for (int eh = 0; eh < 2; ++eh) {
        if (SAMPLE) stage_t<256, 128>(KL, 528, SrcF32{vf + eh * 128, (size_t)1024}, tid); else stage_t<256, 128>(KL, 528, SrcBf16{kvb + 1024 + eh * 128, (size_t)2048}, tid);
        __syncthreads();
        if (active) {
            f32x4 oa[8];
#pragma unroll
            for (int n = 0; n < 8; ++n) oa[n] = (f32x4){0.f, 0.f, 0.f, 0.f};
#pragma unroll 2
            for (int ks = 0; ks < 8; ++ks) { const int kb = (ks * 32 + 8 * lq) * 2; const bf16x8 xf = frag(PL, l15, 528, kb);
#pragma unroll
                for (int n = 0; n < 8; ++n) oa[n] = MFMA16(frag(KL, 16 * n + l15, 528, kb), xf, oa[n]); }
            if (store_ok) {
#pragma unroll
                for (int n = 0; n < 8; ++n) { u32x2 w; w.x = cvt_pk_bf16(oa[n][0] * inv, oa[n][1] * inv); w.y = cvt_pk_bf16(oa[n][2] * inv, oa[n][3] * inv);
                    *(u32x2*)(O + (size_t)tok * DM + h * 256 + eh * 128 + 16 * n + 4 * lq) = w; } }
        }
        __syncthreads();
    }
}

__device__ __forceinline__ void unit_cross_sample(const Params& P, LAS unsigned char* L, int layer, int item, int tid, int lane, int wave) {
    unsigned char* ws = opq(P.ws); const bf16_t* Q = (const bf16_t*)(ws + WS_Q); bf16_t* O = (bf16_t*)(ws + WS_AB);
    const int l15 = lane & 15, lq = lane >> 4;
    asm volatile("" : "+v"(tid));
    const int h = item & 3, bs = item >> 2; const int tok = NP + bs * 8 + (l15 & 7);
    const float* kf = P.in[5] + ((size_t)(layer * 128 + bs) * 256) * 1024 + h * 256; const float* vf = P.in[6] + ((size_t)(layer * 128 + bs) * 256) * 1024 + h * 256;
    LAS unsigned char* KL = L; LAS unsigned char* PL = L + 36864;
    f32x4 RA[8], RB[8];
#define XS_LOADN(R, base) do { _Pragma("unroll") for (int k = 0; k < 4; ++k) { const int it = tid + 512 * k, r = it >> 3, cq = it & 7; const f32x4* p = (const f32x4*)((base) + (size_t)r * 1024 + cq * 8); R[2 * k] = p[0]; R[2 * k + 1] = p[1]; } } while (0)
#define XS_STOREN(R) do { _Pragma("unroll") for (int k = 0; k < 4; ++k) { const int it = tid + 512 * k, r = it >> 3, cq = it & 7; *(LAS u32x4*)(KL + r * 144 + cq * 16) = pack8(R[2 * k], R[2 * k + 1]); } } while (0)
#define XS_LOADT(R, base) do { _Pragma("unroll") for (int k = 0; k < 2; ++k) { const int it = tid + 512 * k, rp = it & 127, cq = it >> 7; const f32x4* p = (const f32x4*)((base) + (size_t)(2 * rp) * 1024 + cq * 8); \
        R[4 * k] = p[0]; R[4 * k + 1] = p[1]; R[4 * k + 2] = p[256]; R[4 * k + 3] = p[257]; } } while (0)
#define XS_STORET(R) do { _Pragma("unroll") for (int k = 0; k < 2; ++k) { const int it = tid + 512 * k, rp = it & 127, cq = it >> 7; const u32x4 a = pack8(R[4 * k], R[4 * k + 1]), b = pack8(R[4 * k + 2], R[4 * k + 3]); \
        LAS unsigned char* d = KL + (cq * 8) * 528 + rp * 4; _Pragma("unroll") for (int e = 0; e < 4; ++e) { *(LAS unsigned*)(d + (2 * e) * 528) = (a[e] & 0xffffu) | (b[e] << 16); *(LAS unsigned*)(d + (2 * e + 1) * 528) = (a[e] >> 16) | (b[e] & 0xffff0000u); } } } while (0)
#define XS_QK(dq) do { _Pragma("unroll") for (int ks = 0; ks < 2; ++ks) { const int kb = (ks * 32 + 8 * lq) * 2; const bf16x8 qf = *(const bf16x8*)(Q + (size_t)tok * DM + h * 256 + (dq) * 64 + ks * 32 + 8 * lq); \
        sc[0] = MFMA16(frag(KL, 32 * wave + l15, 144, kb), qf, sc[0]); sc[1] = MFMA16(frag(KL, 32 * wave + 16 + l15, 144, kb), qf, sc[1]); } } while (0)
#define XS_PV(eq) do { if (wave < 4) { f32x4 oa = (f32x4){0.f, 0.f, 0.f, 0.f}; \
        _Pragma("unroll") for (int ks = 0; ks < 8; ++ks) { const int kb = (ks * 32 + 8 * lq) * 2; oa = MFMA16(frag(KL, 16 * wave + l15, 528, kb), frag(PL, l15, 528, kb), oa); } \
        if (l15 < 8) { u32x2 w; w.x = cvt_pk_bf16(oa[0] * inv, oa[1] * inv); w.y = cvt_pk_bf16(oa[2] * inv, oa[3] * inv); \
            *(u32x2*)(O + (size_t)tok * DM + h * 256 + (eq) * 64 + 16 * wave + 4 * lq) = w; } } } while (0)
    LAS float* redm = (LAS float*)(L + 36864 + 8448); LAS float* reds = redm + 128;
    f32x4 sc[2]; sc[0] = (f32x4){0.f, 0.f, 0.f, 0.f}; sc[1] = sc[0];
    float inv = 0.f;
    XS_LOADN(RA, kf); XS_LOADN(RB, kf + 64);
    XS_STOREN(RA); XS_LOADN(RA, kf + 128); __syncthreads(); XS_QK(0); __syncthreads();
    XS_STOREN(RB); XS_LOADN(RB, kf + 192); __syncthreads(); XS_QK(1); __syncthreads();
    XS_STOREN(RA); XS_LOADT(RA, vf);       __syncthreads(); XS_QK(2); __syncthreads();
    XS_STOREN(RB); XS_LOADT(RB, vf + 64);  __syncthreads(); XS_QK(3);
    {
        float m = fmaxf(fmaxf(fmaxf(sc[0][0], sc[0][1]), fmaxf(sc[0][2], sc[0][3])), fmaxf(fmaxf(sc[1][0], sc[1][1]), fmaxf(sc[1][2], sc[1][3])));
        m = fmaxf(m, __shfl_xor(m, 16)); m = fmaxf(m, __shfl_xor(m, 32));
        if (lq == 0) redm[wave * 16 + l15] = m;
        __syncthreads();
#pragma unroll
        for (int w = 0; w < 8; ++w) m = fmaxf(m, redm[w * 16 + l15]);
        float ssum = 0.f;
#pragma unroll
        for (int n = 0; n < 2; ++n) { float p[4];
#pragma unroll
            for (int r = 0; r < 4; ++r) { p[r] = fexp(sc[n][r] - m); ssum += p[r]; }
            u32x2 w; w.x = cvt_pk_bf16(p[0], p[1]); w.y = cvt_pk_bf16(p[2], p[3]); *(LAS u32x2*)(PL + l15 * 528 + (32 * wave + 16 * n + 4 * lq) * 2) = w; }
        ssum += __shfl_xor(ssum, 16); ssum += __shfl_xor(ssum, 32);
        if (lq == 0) reds[wave * 16 + l15] = ssum;
    }
    XS_STORET(RA); XS_LOADT(RA, vf + 128); __syncthreads();
    { float t = 0.f;
#pragma unroll
        for (int w = 0; w < 8; ++w) t += reds[w * 16 + l15];
        inv = 1.0f / t; }
    XS_PV(0); __syncthreads();
    XS_STORET(RB); XS_LOADT(RB, vf + 192); __syncthreads(); XS_PV(1); __syncthreads();
    XS_STORET(RA);                         __syncthreads(); XS_PV(2); __syncthreads();
    XS_STORET(RB);                         __syncthreads(); XS_PV(3); __syncthreads();
#undef XS_QK
#undef XS_PV
#undef XS_LOADN
#undef XS_STOREN
#undef XS_LOADT
#undef XS_STORET
}

template <bool SAMPLE> __device__ __forceinline__ void unit_swa(const Params& P, LAS unsigned char* L, int item, int tid, int lane, int wave) {
    constexpr int NKT = 10, NKEY = NKT * 16;
    unsigned char* ws = opq(P.ws); const bf16_t* QKV = (const bf16_t*)(ws + WS_Z); bf16_t* O = (bf16_t*)(ws + WS_AB);
    const int l15 = lane & 15, lq = lane >> 4;
    LAS unsigned char* KL = L; LAS unsigned char* VT = L + 36864; LAS unsigned char* PL = L + 36864 + 33792 + wave * 8448;
    const int kvh = item & 3; int qb = 0, b = 0, bs = 0;
    if (SAMPLE) { bs = item >> 2;
        const float* ck = P.in[3] + ((size_t)bs * 128 * 4 + kvh) * 64; const float* cv = P.in[4] + ((size_t)bs * 128 * 4 + kvh) * 64;
        const bf16_t* nk = QKV + (size_t)(NP + bs * 8) * QKVW + 1024 + kvh * 64; const bf16_t* nv = nk + 256;
        stage_n<128, 64>(KL, 144, SrcF32{ck, (size_t)256}, tid);
        stage_n<32, 64>(KL, 144, SrcTail{nk}, tid, 128);
        stage_t<128, 64>(VT, 528, SrcF32{cv, (size_t)256}, tid);
        stage_t<32, 64>(VT, 528, SrcTail{nv}, tid, 128);
        float* wk = opq(P.out) + O_WKS + ((size_t)bs * 128 * 4 + kvh) * 64; float* wv = opq(P.out) + O_WVS + ((size_t)bs * 128 * 4 + kvh) * 64;
        for (int it = tid; it < 128 * 16; it += 512) { const int w = it >> 4, c4 = (it & 15) * 4, jj = w + 8; f32x4 a, bb;
            if (jj < 128) { a = *(const f32x4*)(ck + (size_t)jj * 256 + c4); bb = *(const f32x4*)(cv + (size_t)jj * 256 + c4); }
            else { const u32x2 ka = *(const u32x2*)(nk + (size_t)(jj - 128) * QKVW + c4), va = *(const u32x2*)(nv + (size_t)(jj - 128) * QKVW + c4);
                a = (f32x4){bf2f(ka.x & 0xffffu), bf2f(ka.x >> 16), bf2f(ka.y & 0xffffu), bf2f(ka.y >> 16)}; bb = (f32x4){bf2f(va.x & 0xffffu), bf2f(va.x >> 16), bf2f(va.y & 0xffffu), bf2f(va.y >> 16)}; }
            *(f32x4*)(wk + (size_t)w * 256 + c4) = a; *(f32x4*)(wv + (size_t)w * 256 + c4) = bb; }
    } else { qb = (item >> 2) & 15; b = item >> 6;
        const bf16_t* kb0 = QKV + ((size_t)b * SEQ + qb * 128 - 128) * QKVW + 1024 + kvh * 64;
        const int zb = qb == 0 ? 128 : 0;
        stage_n<256, 64>(KL, 144, SrcBf16Z{kb0, (size_t)QKVW, zb}, tid);
        stage_t<256, 64>(VT, 528, SrcBf16Z{kb0 + 256, (size_t)QKVW, zb}, tid);
    }
    __syncthreads();
    constexpr int NRT = SAMPLE ? 4 : 32;
    for (int rt = wave; rt < NRT; rt += 8) {
        int g, i, tok;
        if (SAMPLE) { g = rt; i = l15 & 7; tok = NP + bs * 8 + i; }
        else { g = rt >> 3; i = (rt & 7) * 16 + l15; tok = b * SEQ + qb * 128 + i; }
        const int head = kvh * 4 + g;
        const bf16_t* qp = QKV + (size_t)tok * QKVW + head * 64 + 8 * lq;
        const bf16x8 q0 = *(const bf16x8*)qp, q1 = *(const bf16x8*)(qp + 32);
        const int ylo = SAMPLE ? 0 : (wave > 0 ? wave - 1 : 0);
        f32x4 sc[NKT];
#pragma unroll
        for (int y = 0; y < NKT; ++y) { sc[y] = (f32x4){0.f, 0.f, 0.f, 0.f};
            sc[y] = MFMA16(frag(KL, 16 * (ylo + y) + l15, 144, (8 * lq) * 2), q0, sc[y]); sc[y] = MFMA16(frag(KL, 16 * (ylo + y) + l15, 144, (32 + 8 * lq) * 2), q1, sc[y]);
            if ((y & 1) == 1) __builtin_amdgcn_sched_barrier(0); }
        const int jlo = (!SAMPLE && qb == 0) ? 128 : 0;
#pragma unroll
        for (int y = 0; y < NKT; ++y)
#pragma unroll
            for (int r = 0; r < 4; ++r) { const int jj = 16 * (ylo + y) + 4 * lq + r; const bool valid = (jj > i) && (jj <= i + 128) && (jj >= jlo); sc[y][r] = valid ? sc[y][r] * 0.125f : -INFINITY; }
        const float sink = P.in[17][head];
        const float inv = softmax_rows<NKT>(sc, PL, l15, lq, sink);
        asm volatile("s_waitcnt lgkmcnt(0)" ::: "memory");
        f32x4 oa[4];
#pragma unroll
        for (int n = 0; n < 4; ++n) oa[n] = (f32x4){0.f, 0.f, 0.f, 0.f};
#pragma unroll 2
        for (int ks = 0; ks < NKT / 2; ++ks) { const int kb = (ks * 32 + 8 * lq) * 2; const bf16x8 xf = frag(PL, l15, 528, kb);
#pragma unroll
            for (int n = 0; n < 4; ++n) oa[n] = MFMA16(frag(VT, 16 * n + l15, 528, kb + 32 * ylo), xf, oa[n]); }
        if (!SAMPLE || l15 < 8) {
#pragma unroll
            for (int n = 0; n < 4; ++n) { u32x2 w; w.x = cvt_pk_bf16(oa[n][0] * inv, oa[n][1] * inv); w.y = cvt_pk_bf16(oa[n][2] * inv, oa[n][3] * inv);
                *(u32x2*)(O + (size_t)tok * DM + head * 64 + 16 * n + 4 * lq) = w; } }
        asm volatile("s_waitcnt lgkmcnt(0)" ::: "memory");
    }
}

__device__ __forceinline__ void unit_swa_sample(const Params& P, LAS unsigned char* L, int item, int tid, int lane, int wave) {
    unsigned char* ws = opq(P.ws); const bf16_t* QKV = (const bf16_t*)(ws + WS_Z); bf16_t* O = (bf16_t*)(ws + WS_AB);
    asm volatile("" : "+v"(tid));
    const int kvh = item & 3, bs = item >> 2;
    LAS float* Kf = (LAS float*)L;
    LAS float* Vf = (LAS float*)(L + 36992);
    LAS float* Qf = (LAS float*)(L + 36992 + 34816);
    LAS float* Pf = (LAS float*)(L + 36992 + 34816 + 8192);
    const float* ck = P.in[3] + ((size_t)bs * 128 * 4 + kvh) * 64; const float* cv = P.in[4] + ((size_t)bs * 128 * 4 + kvh) * 64;
    const bf16_t* nk = QKV + (size_t)(NP + bs * 8) * QKVW + 1024 + kvh * 64; const bf16_t* nv = nk + 256;
    float* wk = opq(P.out) + O_WKS + ((size_t)bs * 128 * 4 + kvh) * 64; float* wv = opq(P.out) + O_WVS + ((size_t)bs * 128 * 4 + kvh) * 64;
    for (int it = tid; it < 136 * 16; it += 512) { const int jj = it >> 4, d = (it & 15) * 4; f32x4 kx, vx;
        if (jj < 128) { kx = *(const f32x4*)(ck + (size_t)jj * 256 + d); vx = *(const f32x4*)(cv + (size_t)jj * 256 + d); }
        else { const u32x2 ka = *(const u32x2*)(nk + (size_t)(jj - 128) * QKVW + d), va = *(const u32x2*)(nv + (size_t)(jj - 128) * QKVW + d);
            kx = (f32x4){bf2f(ka.x & 0xffffu), bf2f(ka.x >> 16), bf2f(ka.y & 0xffffu), bf2f(ka.y >> 16)}; vx = (f32x4){bf2f(va.x & 0xffffu), bf2f(va.x >> 16), bf2f(va.y & 0xffffu), bf2f(va.y >> 16)}; }
        *(LAS f32x4*)(Kf + jj * 68 + d) = kx; *(LAS f32x4*)(Vf + jj * 64 + d) = vx;
        if (jj >= 8) { *(f32x4*)(wk + (size_t)(jj - 8) * 256 + d) = kx; *(f32x4*)(wv + (size_t)(jj - 8) * 256 + d) = vx; } }
    { const int r = tid >> 4, d = (tid & 15) * 4, g = r >> 3, i = r & 7;
        const u32x2 qa = *(const u32x2*)(QKV + (size_t)(NP + bs * 8 + i) * QKVW + (kvh * 4 + g) * 64 + d);
        *(LAS f32x4*)(Qf + r * 64 + d) = (f32x4){bf2f(qa.x & 0xffffu), bf2f(qa.x >> 16), bf2f(qa.y & 0xffffu), bf2f(qa.y >> 16)}; }
    __syncthreads();
    for (int idx = tid; idx < 32 * 136; idx += 512) { const int r = idx / 136, jj = idx - r * 136, i = r & 7; f32x4 sa = (f32x4){0.f, 0.f, 0.f, 0.f};
#pragma unroll 4
        for (int d = 0; d < 64; d += 4) sa += *(const LAS f32x4*)(Qf + r * 64 + d) * *(const LAS f32x4*)(Kf + jj * 68 + d);
        const float sacc = (sa[0] + sa[1]) + (sa[2] + sa[3]);
        Pf[r * 144 + jj] = ((jj > i) && (jj <= i + 128)) ? sacc * 0.125f : -INFINITY; }
    __syncthreads();
    const int r = tid >> 4, t = tid & 15, g = r >> 3, i = r & 7, head = kvh * 4 + g;
    const float sink = P.in[17][head];
    float m = sink;
    for (int jj = t; jj < 136; jj += 16) m = fmaxf(m, Pf[r * 144 + jj]);
#pragma unroll
    for (int o = 1; o < 16; o <<= 1) m = fmaxf(m, __shfl_xor(m, o));
    float ssum = 0.f;
    for (int jj = t; jj < 136; jj += 16) { const float p = fexp(Pf[r * 144 + jj] - m); Pf[r * 144 + jj] = p; ssum += p; }
#pragma unroll
    for (int o = 1; o < 16; o <<= 1) ssum += __shfl_xor(ssum, o);
    const float inv = 1.0f / (ssum + fexp(sink - m));
    __syncthreads();
    f32x4 oacc = (f32x4){0.f, 0.f, 0.f, 0.f};
#pragma unroll 4
    for (int jj = 0; jj < 136; jj += 4) { const f32x4 p = *(const LAS f32x4*)(Pf + r * 144 + jj);
        oacc += *(const LAS f32x4*)(Vf + jj * 64 + 4 * t) * p[0]; oacc += *(const LAS f32x4*)(Vf + (jj + 1) * 64 + 4 * t) * p[1];
        oacc += *(const LAS f32x4*)(Vf + (jj + 2) * 64 + 4 * t) * p[2]; oacc += *(const LAS f32x4*)(Vf + (jj + 3) * 64 + 4 * t) * p[3]; }
    u32x2 w; w.x = cvt_pk_bf16(oacc[0] * inv, oacc[1] * inv); w.y = cvt_pk_bf16(oacc[2] * inv, oacc[3] * inv);
    *(u32x2*)(O + (size_t)(NP + bs * 8 + i) * DM + head * 64 + 4 * t) = w;
}

__device__ __forceinline__ void phase_final(const Params& P, int lane, int wave) {
    const bf16_t* XB = (const bf16_t*)(opq(P.ws) + WS_XN); const float* rss = (const float*)(opq(P.ws) + WS_RSS); const float* g = P.in[29]; float* Y = opq(P.out) + O_Y;
    const int gw = blockIdx.x * 8 + wave, NGW = gridDim.x * 8;
    f32x4 gg[4];
#pragma unroll
    for (int j = 0; j < 4; ++j) gg[j] = *(const f32x4*)(g + 8 * lane + 512 * (j >> 1) + 4 * (j & 1));
    for (int row = gw; row < NTOK; row += NGW) { const float r = rss_scale(rss, row);
#pragma unroll
        for (int j = 0; j < 2; ++j) { const int c = 8 * lane + 512 * j; f32x4 a, b; pg8::unpack8(*(const u32x4*)(XB + (size_t)row * DM + c), a, b);
            __builtin_nontemporal_store(a * r * gg[2 * j], (f32x4*)(Y + (size_t)row * DM + c)); __builtin_nontemporal_store(b * r * gg[2 * j + 1], (f32x4*)(Y + (size_t)row * DM + c + 4)); } }
}

constexpr int NPHASE = 21;
__global__ void __launch_bounds__(512) fwd_kernel(Params P) {
    extern __shared__ __attribute__((aligned(16))) unsigned char lds_raw[];
    LAS unsigned char* L = (LAS unsigned char*)lds_raw;
    const int G = gridDim.x, bx = blockIdx.x;
    const int lo = P.ph_lo, hi = P.ph_hi;
    if (threadIdx.x < 2) ((LAS unsigned*)(L + SLOT_OFF + 16))[threadIdx.x] = 0u;
    __syncthreads();
    XcdBarrier xbar; xbar.bar = (unsigned*)(P.ws + WS_CTL) + 4096; xbar.x = 0; xbar.st = (volatile LAS unsigned*)(L + SLOT_OFF + 16);
    if (hi - lo > 1) xbar = xcd_barrier_post((unsigned*)(P.ws + WS_CTL) + 4096, (volatile LAS unsigned*)(L + SLOT_OFF + 16));
    using pg8::Gemm; using pg8::StaticOrder; using pg8::EpiAct; using pg8::EpiRes; using pg8::EpiMem;
#ifndef PHASE_MASK
#define PHASE_MASK 0x1fffff
#endif
    const int rp = (P.pmask >> 21) & 31, rc = (P.pmask >> 26) & 7;
#pragma unroll 1
    for (int step = lo; step < hi + rc; ++step) {
        const int ph = step <= rp ? step : (step <= rp + rc ? rp : step - rc);
        const int rep = step <= rp ? 0 : (step <= rp + rc ? step - rp : 0);
        int tid = threadIdx.x; asm volatile("" : "+v"(tid));
        const int lane = tid & 63, wave = __builtin_amdgcn_readfirstlane(tid >> 6);
        unsigned char* ws = opq(P.ws);
        unsigned* ctl = (unsigned*)(ws + WS_CTL);
        bf16_t* XN = (bf16_t*)(ws + WS_XN); float* rss = (float*)(ws + WS_RSS);
        bf16_t* Z = (bf16_t*)(ws + WS_Z); bf16_t* AB = (bf16_t*)(ws + WS_AB); bf16_t* Qb = (bf16_t*)(ws + WS_Q);
        if (((PHASE_MASK & P.pmask) >> ph) & 1) {
            int kind = 0;
            const bf16_t* A = XN; const bf16_t* Bt = nullptr; int N = DM, K = 1024;
            bf16_t* Optr = Z; int ldc = DM; const float* biasp = nullptr; float scale = 1.0f; int act = 0, actc = 0;
            const float* xa = nullptr; const float* xb = nullptr; int split = NTOK;
            const int l = ph >= 15 ? 1 : 0;
            switch (ph) {
                case 1: kind = 1; Bt = (const bf16_t*)(ws + WS_WIN); N = ZW; Optr = Z; ldc = ZW; act = 1; actc = 2048; break;
                case 5: kind = 2; A = AB; Bt = (const bf16_t*)(ws + WS_WOUTE); K = 2048; xa = P.in[0]; xb = P.in[1]; split = NP; break;
                case 6: case 15: kind = 1; Bt = (const bf16_t*)(ws + WS_WMQ + l * 2 * MiB); Optr = Qb; scale = 0.0625f; break;
                case 8: case 17: kind = 2; A = AB; Bt = (const bf16_t*)(ws + WS_WMO + l * 2 * MiB); break;
                case 9: case 18: kind = 1; Bt = (const bf16_t*)(ws + WS_WUP + l * 8 * MiB); N = FF; Optr = Z; ldc = FF; act = 2; break;
                case 10: case 19: kind = 2; A = Z; Bt = (const bf16_t*)(ws + WS_WDOWN + l * 8 * MiB); K = 4096; break;
                case 11: kind = 1; Bt = (const bf16_t*)(ws + WS_WQKV); N = QKVW; Optr = Z; ldc = QKVW; biasp = P.in[16]; break;
                case 14: kind = 2; A = AB; Bt = (const bf16_t*)(ws + WS_WOUTO); biasp = P.in[19]; break;
                default: break;
            }
            if (kind == 1) {
                const bool all_big = (ph == 11 || ph == 1 || ph == 9 || ph == 18);
                const int Mbig = all_big ? NTOK : NP;
                Gemm g{A, Bt, Mbig, N, K}; StaticOrder S; S.init(Mbig, N, G, bx);
                EpiAct E{Optr, ldc, rss, biasp, scale, act, actc}; pg8::gemm_phase<EpiAct, StaticOrder, true, true>(L, g, S, E, tid);
                if (!all_big) gemm_small(L, A + (size_t)NP * K, Bt, N, K, RowAct{Optr, ldc, rss, biasp, scale, act, actc}, tid, lane, wave);
                if (ph == 1) {
#pragma unroll 1
                    for (int ll = 0; ll < 2; ++ll) { Gemm g2{(const bf16_t*)(ws + WS_MN + ll * 4 * MiB), (const bf16_t*)(ws + WS_WMKV + ll * 4 * MiB), 2048, 2048, 1024}; StaticOrder S2; S2.init(2048, 2048, G, ((bx - 80 - 64 * ll) % G + G) % G);
                        EpiMem E2{opq(P.out) + O_MEMK + (size_t)ll * 2048 * 1024, opq(P.out) + O_MEMV + (size_t)ll * 2048 * 1024, (bf16_t*)(ws + WS_MKV + ll * 8 * MiB)}; pg8::gemm_phase<EpiMem, StaticOrder, true, true>(L, g2, S2, E2, tid); }
                }
            } else if (kind == 2) {
                Gemm g{A, Bt, NP, DM, K}; StaticOrder S; S.init(NP, DM, G, bx);
                EpiRes E{xa, xb, split, XN, biasp, rss}; pg8::gemm_phase<EpiRes, StaticOrder, true, true>(L, g, S, E, tid);
                gemm_small(L, A + (size_t)NP * K, Bt, DM, K, RowRes{xa, xb, split, XN, biasp, rss}, tid, lane, wave);
            } else if (ph == 0) { phase_prologue(P, L, tid, lane, wave);
            } else if (ph == 2) { phase_rowpass_a(P, lane, wave);
            } else if (ph == 3) {
                for (;;) { const int it = next_item(ctl + 64 * (3 + 32 * rep), L); if (it >= 1280) break;
                    const int sel = rep ? ((P.pmask >> 29) & 3) : 0;
                    if (it < 128) { if (sel == 0 || sel == 1) unit_scan(P, L, it, tid, lane, wave); }
                    else if (it < 640) { if (sel == 0 || sel == 2) unit_sgu(P, L, it - 128, tid, lane, wave); }
                    else if (it < 1152) { if (sel == 0 || sel == 3) unit_ret_sample(P, L, it - 640, tid, lane, wave); }
                    else unit_sgu_sample(P, it - 1152, tid); }
            } else if (ph == 4) { for (;;) { const int it = next_item(ctl + 64 * (4 + 32 * rep), L); if (it >= 512) break; unit_ret_out(P, L, it, tid, lane, wave); }
            } else if (ph == 7 || ph == 16) { for (;;) { const int it = next_item(ctl + 64 * (ph + 32 * rep), L); if (it >= 1024) break;
                    const int sel = rep ? ((P.pmask >> 29) & 3) : 0;
                    if (it & 1) { if (sel != 2) unit_cross_sample(P, L, l, it >> 1, tid, lane, wave); } else { if (sel != 1) unit_cross<false>(P, L, l, it >> 1, tid, lane, wave); } }
            } else if (ph == 12) { phase_rowpass_b(P, lane, wave);
            } else if (ph == 13) { for (;;) { const int it = next_item(ctl + 64 * (13 + 32 * rep), L); if (it >= 1024) break;
                    const int sel = rep ? ((P.pmask >> 29) & 3) : 0;
                    if (it & 1) { if (sel != 2) unit_swa_sample(P, L, it >> 1, tid, lane, wave); } else { if (sel != 1) unit_swa<false>(P, L, it >> 1, tid, lane, wave); } }
            } else if (ph == 20) { phase_final(P, lane, wave); }
        }
        if (step + 1 < hi + rc) {
            if (P.ph_lo < 0) cg::this_grid().sync();
            xcd_barrier(xbar);
        }
    }
}

extern "C" void kernel_launch(void* const* d_in, const int* in_sizes, int n_in, void* d_out, int out_size, void* d_ws, size_t ws_size, hipStream_t stream) {
    static int grid = 0;
    if (grid == 0) {
        if (n_in != 30 || ws_size < WS_END) { fprintf(stderr, "kernel_launch: unexpected problem (n_in %d, ws %zu)\n", n_in, ws_size); grid = -1; return; }
        int dev = 0, cus = 0, per_cu = 0;
        (void)hipGetDevice(&dev); (void)hipDeviceGetAttribute(&cus, hipDeviceAttributeMultiprocessorCount, dev);
        if (hipFuncSetAttribute((const void*)fwd_kernel, hipFuncAttributeMaxDynamicSharedMemorySize, LDS_BYTES) != hipSuccess) { fprintf(stderr, "kernel_launch: hipFuncSetAttribute failed\n"); }
        if (hipOccupancyMaxActiveBlocksPerMultiprocessor(&per_cu, (const void*)fwd_kernel, 512, LDS_BYTES) != hipSuccess || per_cu < 1) { fprintf(stderr, "kernel_launch: occupancy query says %d\n", per_cu); per_cu = 1; }
        (void)hipGetLastError();
        grid = cus * 1;
        fprintf(stderr, "kernel_launch: cus %d per_cu %d grid %d\n", cus, per_cu, grid);
    }
    if (grid < 0) return;
    (void)hipMemsetAsync((char*)d_ws + WS_CTL, 0, CTL_BYTES, stream);
    if ((RUN_MASK >> 30) & 1) (void)hipMemsetAsync(d_out, 0, (size_t)out_size * 4, stream);
    Params p{};
    for (int i = 0; i < 30; ++i) p.in[i] = (const float*)d_in[i];
    p.out = (float*)d_out; p.ws = (unsigned char*)d_ws; p.pmask = RUN_MASK | (REP_PHASE << 21) | (REP_COUNT << 26) | (REP_SEL << 29);
    for (int j = 0; j < 64; ++j) p.inv[j] = powf(10000.0f, -(float)j / 64.0f);
    for (int j = 0; j < 32; ++j) p.inv[64 + j] = powf(150000.0f, -(float)j / 32.0f);
#if MK_ONE_LAUNCH
    p.ph_lo = 0; p.ph_hi = NPHASE;
    void* args[] = {&p};
    hipError_t e = hipLaunchCooperativeKernel((const void*)fwd_kernel, dim3(grid), dim3(512), args, LDS_BYTES, stream);
    if (e != hipSuccess) fprintf(stderr, "kernel_launch: cooperative launch failed: %s\n", hipGetErrorString(e));
#else
    for (int ph = 0; ph < NPHASE; ++ph) { p.ph_lo = ph; p.ph_hi = ph + 1; hipLaunchKernelGGL(fwd_kernel, dim3(grid), dim3(512), LDS_BYTES, stream, p); }
#endif
}
```

```cpp
#include <hip/hip_runtime.h>
#include <hip/hip_cooperative_groups.h>
#include <cstdio>
#include <cstdint>
#include <cmath>
namespace cg = cooperative_groups;

#define LAS __attribute__((address_space(3)))
typedef unsigned short bf16_t;
typedef short bf16x8 __attribute__((ext_vector_type(8)));
typedef float f32x4 __attribute__((ext_vector_type(4)));
typedef float f32x2 __attribute__((ext_vector_type(2)));
typedef unsigned u32x4 __attribute__((ext_vector_type(4)));
typedef unsigned u32x2 __attribute__((ext_vector_type(2)));

#ifndef REP_PHASE
#define REP_PHASE 31
#define REP_COUNT 0
#define REP_SEL 0
#endif
#ifndef RUN_MASK
#define RUN_MASK 0x1fffff
#endif
#ifndef MK_ONE_LAUNCH
#define MK_ONE_LAUNCH 1
#endif

constexpr int DM = 1024, NP = 16384, NS = 1024, NTOK = NP + NS, SEQ = 2048;
constexpr int ZW = 5120, QKVW = 1536, FF = 4096;
constexpr float EPS = 1e-6f;
constexpr size_t MiB = 1u << 20;
constexpr size_t WS_CTL = 0, CTL_BYTES = 1 * MiB;
constexpr size_t WS_WIN = 1 * MiB, WS_WOUTE = 11 * MiB, WS_WQKV = 15 * MiB, WS_WOUTO = 18 * MiB, WS_WMQ = 20 * MiB, WS_WMKV = 24 * MiB, WS_WMO = 32 * MiB,
                 WS_WUP = 36 * MiB, WS_WDOWN = 52 * MiB, WS_ROTR = 68 * MiB, WS_ROTC = 70 * MiB, WS_RSS = 71 * MiB, WS_MN = 73 * MiB, WS_MKV = 81 * MiB,
                 WS_X = 97 * MiB, WS_XN = 165 * MiB, WS_Z = 199 * MiB, WS_AB = 369 * MiB, WS_Q = 437 * MiB, WS_ST = 471 * MiB, WS_END = 503 * MiB;
constexpr size_t O_Y = 0, O_MEMK = 17825792, O_MEMV = 22020096, O_RETP = 26214400, O_RETS = 27262976, O_SGUV = 44040192, O_WKP = 45088768, O_WVP = 45350912,
                 O_WKS = 45613056, O_WVS = 49807360;
constexpr int LDS_BYTES = 147456;
constexpr int SLOT_OFF = 147456 - 64;

__device__ __forceinline__ float bf2f(unsigned h) { return __uint_as_float(h << 16); }
typedef __bf16 bf16x2_t __attribute__((ext_vector_type(2)));
__device__ __forceinline__ unsigned cvt_pk_bf16(float lo, float hi) { const f32x2 v = {lo, hi}; const bf16x2_t b = __builtin_convertvector(v, bf16x2_t); return __builtin_bit_cast(unsigned, b); }
__device__ __forceinline__ float wave_sum(float v) {
#pragma unroll
    for (int o = 1; o < 64; o <<= 1) v += __shfl_xor(v, o);
    return v;
}
__device__ __forceinline__ float fexp2(float x) { return __builtin_amdgcn_exp2f(x); }
__device__ __forceinline__ float fexp(float x) { return __builtin_amdgcn_exp2f(x * 1.4426950408889634f); }
__device__ __forceinline__ float gelu_tanh(float x) { const float x2 = x * x; const float t = x * (-2.3022081f - 0.10294324f * x2); return x * __builtin_amdgcn_rcpf(1.0f + __builtin_amdgcn_exp2f(t)); }
__device__ __forceinline__ float silu(float x) { return x * __builtin_amdgcn_rcpf(1.0f + __builtin_amdgcn_exp2f(-1.4426950408889634f * x)); }
__device__ __forceinline__ u32x4 pack8(f32x4 a, f32x4 b) { u32x4 w; w.x = cvt_pk_bf16(a[0], a[1]); w.y = cvt_pk_bf16(a[2], a[3]); w.z = cvt_pk_bf16(b[0], b[1]); w.w = cvt_pk_bf16(b[2], b[3]); return w; }
__device__ __forceinline__ float rss_scale(const float* rss, int row) {
    const f32x4* p = (const f32x4*)(rss + (size_t)row * 16);
    const f32x4 a = p[0], b = p[1], c = p[2], d = p[3];
    const float s = ((a[0] + a[1]) + (a[2] + a[3])) + ((b[0] + b[1]) + (b[2] + b[3])) + ((c[0] + c[1]) + (c[2] + c[3])) + ((d[0] + d[1]) + (d[2] + d[3]));
    return __builtin_amdgcn_rsqf(s * (1.0f / 1024.0f) + EPS);
}
#define MFMA16(y, x, acc) __builtin_amdgcn_mfma_f32_16x16x32_bf16((y), (x), (acc), 0, 0, 0)
__device__ __forceinline__ bf16x8 frag(const LAS unsigned char* base, int row, int pitchB, int kbyte) { return *(const LAS bf16x8*)(base + row * pitchB + kbyte); }

namespace pg8 {
#define PG8_LAS __attribute__((address_space(3)))
constexpr int BM = 256, BK = 64, HALF = 128, HTB = HALF * BK * 2, STAGE_BYTES = 8 * HTB, NXCD = 8, WGM = 8;
__host__ __device__ __forceinline__ int lds_byte(int r, int c) { const int st = (r >> 4) * 2 + (c >> 5), rr = r & 15, cc = c & 31, ob = rr * 64 + cc * 2; return st * 1024 + (ob ^ (((ob >> 9) & 1) << 5)); }
__host__ __device__ __forceinline__ void stage_rc(int b, int& R, int& C) { const int st = b / 1024, sb = b % 1024, swz = sb ^ (((sb >> 9) & 1) << 5); R = (st >> 1) * 16 + swz / 64; C = (st & 1) * 32 + (swz % 64) / 2; }
__host__ __device__ __forceinline__ int perm32(int rho) { const int n = rho >> 4, i = rho & 15; return 8 * (i >> 2) + 4 * n + (i & 3); }
struct Unit { int pm, pn; };
struct Gemm { const bf16_t* A; const bf16_t* Bt; int M, N, K; };
struct StaticOrder {
    int nM, nN, nwg, G, c;
    __host__ __device__ void init(int M, int N, int G_, int c_) { nM = M / BM; nN = N / BM; nwg = nM * nN; G = G_; c = c_; }
    __host__ __device__ bool next(int i, Unit& u) const {
        const long L = (long)i * G + c; if (L >= nwg) return false;
        int wgid = (int)L; { const int q = nwg / NXCD, r = nwg % NXCD, xcd = wgid % NXCD, off = wgid / NXCD; wgid = (xcd < r ? xcd * (q + 1) : r * (q + 1) + (xcd - r) * q) + off; }
        const int nig = WGM * nN, gid = wgid / nig, fm = gid * WGM, gsz = (nM - fm) < WGM ? (nM - fm) : WGM;
        u.pm = fm + ((wgid % nig) % gsz); u.pn = (wgid % nig) / gsz; return true;
    }
    __device__ __forceinline__ void a_ready(const Unit&) const {}
    __device__ __forceinline__ void done(const Unit&) const {}
};

template <class Epi, class Sched, bool ALIGN_EPI = false, bool SP2 = false>
__device__ __forceinline__ void gemm_phase(PG8_LAS unsigned char* lds, const Gemm g, const Sched& S, const Epi& E, const int tid) {
    const int wid = __builtin_amdgcn_readfirstlane(tid >> 6), lane = tid & 63, wr = wid >> 2, wc = wid & 3, fr = lane & 15, fq = lane >> 4;
    const int K = g.K, nt = K / BK;
    unsigned voffA[2], voffB[2];
#pragma unroll
    for (int i = 0; i < 2; ++i) { int R, C; stage_rc(tid * 16 + i * 8192, R, C); const int Rb = Epi::PERM ? ((R & ~31) + perm32(R & 31)) : R;
        voffA[i] = (unsigned)(R * K + C) * 2u; voffB[i] = (unsigned)(Rb * K + C) * 2u; }
    const size_t kstep = (size_t)(BK * 2);
    const size_t hstep = (size_t)HALF * K * 2;
    const size_t tstep = 2 * hstep;
    const unsigned ldsw = (unsigned)wid * 1024u;
    const int aoff = lds_byte(wr * 64 + fr, fq * 8), boff = lds_byte(wc * 32 + fr, fq * 8);
#define PG8_SA(b, h) (((b) * 2 + (h)) * HTB)
#define PG8_SB(b, h) ((4 + (b) * 2 + (h)) * HTB)
#define PG8_STAGE(bufoff, gbase, voff) do { _Pragma("unroll") for (int _i = 0; _i < 2; ++_i) \
        __builtin_amdgcn_global_load_lds((const unsigned*)((const char*)(gbase) + (voff)[_i]), (PG8_LAS unsigned*)(lds + (bufoff) + ldsw + _i * 8192), 16, 0, 0); } while (0)
#define PG8_LDA(dst, b, h) do { _Pragma("unroll") for (int m = 0; m < 4; ++m) _Pragma("unroll") for (int k = 0; k < 2; ++k) dst[m][k] = *(const PG8_LAS bf16x8*)(lds + PG8_SA(b, h) + aoff + m * 2048 + k * 1024); } while (0)
#define PG8_LDB(dst, b, h) do { _Pragma("unroll") for (int n = 0; n < 2; ++n) _Pragma("unroll") for (int k = 0; k < 2; ++k) dst[n][k] = *(const PG8_LAS bf16x8*)(lds + PG8_SB(b, h) + boff + n * 2048 + k * 1024); } while (0)
#define PG8_MMA(ai, bj, At, Bt) do { __builtin_amdgcn_s_setprio(1); _Pragma("unroll") for (int m = 0; m < 4; ++m) _Pragma("unroll") for (int n = 0; n < 2; ++n) _Pragma("unroll") for (int k = 0; k < 2; ++k) \
        acc[ai][bj][m][n] = __builtin_amdgcn_mfma_f32_16x16x32_bf16(Bt[n][k], At[m][k], acc[ai][bj][m][n], 0, 0, 0); __builtin_amdgcn_s_setprio(0); } while (0)
#define PG8_WAIT_V(n) asm volatile("s_waitcnt vmcnt(" #n ")" ::: "memory")
#define PG8_WAIT_L(n) asm volatile("s_waitcnt lgkmcnt(" #n ")" ::: "memory")
#define PG8_BAR __builtin_amdgcn_s_barrier()
#define PG8_SCHED __builtin_amdgcn_sched_barrier(0)
    Unit cur, nxt; int ui = 0;
    if (!S.next(0, cur)) return;
    f32x4 acc[2][2][4][2];
#pragma unroll
    for (int a = 0; a < 2; ++a)
#pragma unroll
        for (int b = 0; b < 2; ++b)
#pragma unroll
            for (int m = 0; m < 4; ++m)
#pragma unroll
                for (int n = 0; n < 2; ++n) acc[a][b][m][n] = (f32x4){0.f, 0.f, 0.f, 0.f};
    bf16x8 At[4][2], B0[2][2], B1[2][2];
    const char* cA = (const char*)g.A + (size_t)cur.pm * tstep; const char* cB = (const char*)g.Bt + (size_t)cur.pn * tstep;
    S.a_ready(cur);
    if constexpr (SP2) {
        PG8_STAGE(PG8_SB(0, 0), cB, voffB); PG8_STAGE(PG8_SB(0, 1), cB + hstep, voffB); PG8_STAGE(PG8_SA(0, 0), cA, voffA); PG8_STAGE(PG8_SA(0, 1), cA + hstep, voffA);
        if (wr == 1) PG8_BAR;
        PG8_WAIT_V(2); PG8_BAR;
        PG8_STAGE(PG8_SB(1, 0), cB + kstep, voffB); PG8_STAGE(PG8_SA(1, 0), cA + kstep, voffA); PG8_STAGE(PG8_SB(1, 1), cB + hstep + kstep, voffB);
        PG8_WAIT_V(6); PG8_BAR;
    } else {
        PG8_STAGE(PG8_SB(0, 0), cB, voffB); PG8_STAGE(PG8_SA(0, 0), cA, voffA); PG8_STAGE(PG8_SB(0, 1), cB + hstep, voffB); PG8_STAGE(PG8_SA(0, 1), cA + hstep, voffA);
        if (wr == 1) PG8_BAR;
        PG8_WAIT_V(4); PG8_BAR;
        PG8_STAGE(PG8_SB(1, 0), cB + kstep, voffB); PG8_STAGE(PG8_SA(1, 0), cA + kstep, voffA); PG8_STAGE(PG8_SB(1, 1), cB + hstep + kstep, voffB);
        PG8_WAIT_V(6); PG8_BAR;
    }
    for (;;) {
        const bool has_next = S.next(ui + 1, nxt);
        const char* nA = has_next ? (const char*)g.A + (size_t)nxt.pm * tstep : cA; const char* nB = has_next ? (const char*)g.Bt + (size_t)nxt.pn * tstep : cB;
        for (int t = 0; t < nt; t += 2) {
            const bool last = (t == nt - 2);
            const char* a1 = cA + (size_t)(t + 1) * kstep;
            const char* a2 = last ? nA : cA + (size_t)(t + 2) * kstep; const char* b2 = last ? nB : cB + (size_t)(t + 2) * kstep;
            const char* a3 = a2 + kstep; const char* b3 = b2 + kstep;
            if (last && has_next) S.a_ready(nxt);
            if constexpr (SP2) {
            PG8_LDB(B0, 0, 0); PG8_LDB(B1, 0, 1); PG8_SCHED; PG8_LDA(At, 0, 0); PG8_STAGE(PG8_SA(1, 1), a1 + hstep, voffA);
            PG8_WAIT_V(8); PG8_WAIT_L(0); PG8_BAR; PG8_MMA(0, 0, At, B0); PG8_MMA(0, 1, At, B1); PG8_BAR; PG8_SCHED;
            PG8_LDA(At, 0, 1); PG8_STAGE(PG8_SB(0, 0), b2, voffB); PG8_STAGE(PG8_SB(0, 1), b2 + hstep, voffB); PG8_STAGE(PG8_SA(0, 0), a2, voffA);
            PG8_WAIT_V(8); PG8_WAIT_L(0); PG8_BAR; PG8_MMA(1, 0, At, B0); PG8_MMA(1, 1, At, B1); PG8_BAR; PG8_SCHED;
            PG8_LDB(B0, 1, 0); PG8_LDB(B1, 1, 1); PG8_SCHED; PG8_LDA(At, 1, 0); PG8_STAGE(PG8_SA(0, 1), a2 + hstep, voffA);
            PG8_WAIT_V(8); PG8_WAIT_L(0); PG8_BAR; PG8_MMA(0, 0, At, B0); PG8_MMA(0, 1, At, B1); PG8_BAR; PG8_SCHED;
            PG8_LDA(At, 1, 1); PG8_STAGE(PG8_SB(1, 0), b3, voffB); PG8_STAGE(PG8_SB(1, 1), b3 + hstep, voffB); PG8_STAGE(PG8_SA(1, 0), a3, voffA);
            PG8_WAIT_V(8); PG8_WAIT_L(0); PG8_BAR; PG8_MMA(1, 0, At, B0); PG8_MMA(1, 1, At, B1); PG8_BAR; PG8_SCHED;
            } else {
            PG8_LDB(B0, 0, 0); PG8_SCHED; PG8_LDA(At, 0, 0); PG8_STAGE(PG8_SA(1, 1), a1 + hstep, voffA);
            PG8_WAIT_L(8); PG8_BAR; PG8_WAIT_L(0); PG8_MMA(0, 0, At, B0); PG8_BAR; PG8_SCHED;
            PG8_LDB(B1, 0, 1); PG8_STAGE(PG8_SB(0, 0), b2, voffB);
            PG8_BAR; PG8_WAIT_L(0); PG8_MMA(0, 1, At, B1); PG8_BAR;
            PG8_LDA(At, 0, 1); PG8_STAGE(PG8_SA(0, 0), a2, voffA);
            PG8_BAR; PG8_WAIT_L(0); PG8_MMA(1, 0, At, B0); PG8_BAR; PG8_SCHED;
            PG8_STAGE(PG8_SB(0, 1), b2 + hstep, voffB);
            PG8_WAIT_V(6); PG8_BAR; PG8_MMA(1, 1, At, B1); PG8_BAR;
            PG8_LDB(B0, 1, 0); PG8_SCHED; PG8_LDA(At, 1, 0); PG8_STAGE(PG8_SA(0, 1), a2 + hstep, voffA);
            PG8_WAIT_L(8); PG8_BAR; PG8_WAIT_L(0); PG8_MMA(0, 0, At, B0); PG8_BAR; PG8_SCHED;
            PG8_LDB(B1, 1, 1); PG8_STAGE(PG8_SB(1, 0), b3, voffB);
            PG8_BAR; PG8_WAIT_L(0); PG8_MMA(0, 1, At, B1); PG8_BAR;
            PG8_LDA(At, 1, 1); PG8_STAGE(PG8_SA(1, 0), a3, voffA);
            PG8_BAR; PG8_WAIT_L(0); PG8_MMA(1, 0, At, B0); PG8_BAR; PG8_SCHED;
            PG8_STAGE(PG8_SB(1, 1), b3 + hstep, voffB);
            PG8_WAIT_V(6); PG8_BAR; PG8_MMA(1, 1, At, B1); PG8_BAR;
            }
        }
        if constexpr (ALIGN_EPI) { if (wr == 0) PG8_BAR; }
        E(acc, cur, wr, wc, fr, fq); S.done(cur);
        if (!has_next) break;
#pragma unroll
        for (int a = 0; a < 2; ++a)
#pragma unroll
            for (int b = 0; b < 2; ++b)
#pragma unroll
                for (int m = 0; m < 4; ++m)
#pragma unroll
                    for (int n = 0; n < 2; ++n) acc[a][b][m][n] = (f32x4){0.f, 0.f, 0.f, 0.f};
        cur = nxt; cA = nA; cB = nB; ++ui;
        if constexpr (ALIGN_EPI) { if (wr == 1) PG8_BAR; }
    }
    PG8_WAIT_V(0);
    if constexpr (!ALIGN_EPI) { if (wr == 0) PG8_BAR; }
    PG8_BAR;
#undef PG8_SA
#undef PG8_SB
#undef PG8_STAGE
#undef PG8_LDA
#undef PG8_LDB
#undef PG8_MMA
#undef PG8_WAIT_V
#undef PG8_WAIT_L
#undef PG8_BAR
#undef PG8_SCHED
}

struct EpiAct {
    static constexpr bool PERM = true;
    bf16_t* O; int ldc; const float* rss; const float* bias; float scale; int act; int act_cols;
    __device__ __forceinline__ void operator()(const f32x4 (&acc)[2][2][4][2], const Unit& u, int wr, int wc, int fr, int fq) const {
        const int row0 = u.pm * BM + wr * 64 + fr, col0 = u.pn * BM + wc * 32 + 8 * fq;
        f32x4 bv[2][2];
#pragma unroll
        for (int bj = 0; bj < 2; ++bj)
#pragma unroll
            for (int n = 0; n < 2; ++n) bv[bj][n] = bias ? *(const f32x4*)(bias + col0 + bj * HALF + 4 * n) : (f32x4){0.f, 0.f, 0.f, 0.f};
        const bool do_gelu = (act == 1) && (u.pn * BM < act_cols);
#pragma unroll
        for (int ai = 0; ai < 2; ++ai)
#pragma unroll
            for (int m = 0; m < 4; ++m) {
                const int row = row0 + ai * HALF + m * 16;
                const float sc = rss ? rss_scale(rss, row) * scale : scale;
                bf16_t* rowp = O + (size_t)row * ldc + col0;
#pragma unroll
                for (int bj = 0; bj < 2; ++bj) {
                    f32x4 v0 = acc[ai][bj][m][0] * sc + bv[bj][0], v1 = acc[ai][bj][m][1] * sc + bv[bj][1];
                    if (do_gelu) {
#pragma unroll
                        for (int e = 0; e < 4; ++e) { v0[e] = gelu_tanh(v0[e]); v1[e] = gelu_tanh(v1[e]); }
                    } else if (act == 2) {
#pragma unroll
                        for (int e = 0; e < 4; ++e) { const float a = fmaxf(v0[e], 0.f), b = fmaxf(v1[e], 0.f); v0[e] = a * a; v1[e] = b * b; }
                    }
                    *(u32x4*)(rowp + bj * HALF) = pack8(v0, v1);
                }
            }
    }
};
__device__ __forceinline__ void unpack8(u32x4 w, f32x4& a, f32x4& b) { a = (f32x4){bf2f(w.x & 0xffffu), bf2f(w.x >> 16), bf2f(w.y & 0xffffu), bf2f(w.y >> 16)}; b = (f32x4){bf2f(w.z & 0xffffu), bf2f(w.z >> 16), bf2f(w.w & 0xffffu), bf2f(w.w >> 16)}; }
struct EpiRes {
    static constexpr bool PERM = true;
    const float* xa; const float* xb; int split_row; bf16_t* XB; const float* bias; float* rss;
    __device__ __forceinline__ void operator()(const f32x4 (&acc)[2][2][4][2], const Unit& u, int wr, int wc, int fr, int fq) const {
        const int row0 = u.pm * BM + wr * 64 + fr, col0 = u.pn * BM + wc * 32 + 8 * fq;
        f32x4 bv[2][2];
#pragma unroll
        for (int bj = 0; bj < 2; ++bj)
#pragma unroll
            for (int n = 0; n < 2; ++n) bv[bj][n] = bias ? *(const f32x4*)(bias + col0 + bj * HALF + 4 * n) : (f32x4){0.f, 0.f, 0.f, 0.f};
#pragma unroll
        for (int ai = 0; ai < 2; ++ai)
#pragma unroll
            for (int m = 0; m < 4; ++m) {
                const int row = row0 + ai * HALF + m * 16;
                float ss = 0.f;
#pragma unroll
                for (int bj = 0; bj < 2; ++bj) {
                    const int c = col0 + bj * HALF;
                    f32x4 o0, o1;
                    if (xa) { const float* src = (row < split_row) ? xa + (size_t)row * DM : xb + (size_t)(row - split_row) * DM; o0 = *(const f32x4*)(src + c); o1 = *(const f32x4*)(src + c + 4); }
                    else unpack8(*(const u32x4*)(XB + (size_t)row * DM + c), o0, o1);
                    const f32x4 v0 = acc[ai][bj][m][0] + bv[bj][0] + o0, v1 = acc[ai][bj][m][1] + bv[bj][1] + o1;
                    ss += (v0[0] * v0[0] + v0[1] * v0[1]) + (v0[2] * v0[2] + v0[3] * v0[3]) + (v1[0] * v1[0] + v1[1] * v1[1]) + (v1[2] * v1[2] + v1[3] * v1[3]);
                    *(u32x4*)(XB + (size_t)row * DM + c) = pack8(v0, v1);
                }
                ss += __shfl_xor(ss, 16); ss += __shfl_xor(ss, 32);
                if (fq == 0) rss[(size_t)row * 16 + u.pn * 4 + wc] = ss;
            }
    }
};
struct EpiMem {
    static constexpr bool PERM = true;
    float* outK; float* outV; bf16_t* MKV;
    __device__ __forceinline__ void operator()(const f32x4 (&acc)[2][2][4][2], const Unit& u, int wr, int wc, int fr, int fq) const {
        const int row0 = u.pm * BM + wr * 64 + fr, col0 = u.pn * BM + wc * 32 + 8 * fq;
        float* ob = (col0 >= 1024) ? outV : outK;
#pragma unroll
        for (int ai = 0; ai < 2; ++ai)
#pragma unroll
            for (int m = 0; m < 4; ++m) {
                const int row = row0 + ai * HALF + m * 16;
#pragma unroll
                for (int bj = 0; bj < 2; ++bj) {
                    const int c = col0 + bj * HALF;
                    const f32x4 v0 = acc[ai][bj][m][0], v1 = acc[ai][bj][m][1];
                    float* op = ob + (size_t)row * 1024 + (c & 1023);
                    __builtin_nontemporal_store(v0, (f32x4*)op); __builtin_nontemporal_store(v1, (f32x4*)(op + 4));
                    *(u32x4*)(MKV + (size_t)row * 2048 + c) = pack8(v0, v1);
                }
            }
    }
};
}

struct RowAct {
    bf16_t* O; int ldc; const float* rss; const float* bias; float scale; int act; int act_cols;
    __device__ __forceinline__ void operator()(int row, int col, f32x4 v0, f32x4 v1, int tid) const {
        const float sc = rss ? rss_scale(rss, row) * scale : scale;
        f32x4 b0 = (f32x4){0.f, 0.f, 0.f, 0.f}, b1 = b0; if (bias) { b0 = *(const f32x4*)(bias + col); b1 = *(const f32x4*)(bias + col + 4); }
        v0 = v0 * sc + b0; v1 = v1 * sc + b1;
        if (act == 1 && col < act_cols) {
#pragma unroll
            for (int e = 0; e < 4; ++e) { v0[e] = gelu_tanh(v0[e]); v1[e] = gelu_tanh(v1[e]); }
        } else if (act == 2) {
#pragma unroll
            for (int e = 0; e < 4; ++e) { const float a = fmaxf(v0[e], 0.f), b = fmaxf(v1[e], 0.f); v0[e] = a * a; v1[e] = b * b; }
        }
        *(u32x4*)(O + (size_t)row * ldc + col) = pack8(v0, v1);
    }
};
struct RowRes {
    const float* xa; const float* xb; int split_row; bf16_t* XB; const float* bias; float* rss;
    __device__ __forceinline__ void operator()(int row, int col, f32x4 v0, f32x4 v1, int tid) const {
        f32x4 b0 = (f32x4){0.f, 0.f, 0.f, 0.f}, b1 = b0; if (bias) { b0 = *(const f32x4*)(bias + col); b1 = *(const f32x4*)(bias + col + 4); }
        f32x4 o0, o1;
        if (xa) { const float* src = (row < split_row) ? xa + (size_t)row * DM : xb + (size_t)(row - split_row) * DM; o0 = *(const f32x4*)(src + col); o1 = *(const f32x4*)(src + col + 4); }
        else pg8::unpack8(*(const u32x4*)(XB + (size_t)row * DM + col), o0, o1);
        v0 = v0 + b0 + o0; v1 = v1 + b1 + o1;
        *(u32x4*)(XB + (size_t)row * DM + col) = pack8(v0, v1);
        float ss = (v0[0] * v0[0] + v0[1] * v0[1]) + (v0[2] * v0[2] + v0[3] * v0[3]) + (v1[0] * v1[0] + v1[1] * v1[1]) + (v1[2] * v1[2] + v1[3] * v1[3]);
        ss += __shfl_xor(ss, 1); ss += __shfl_xor(ss, 2); ss += __shfl_xor(ss, 4);
        if ((tid & 7) == 0) rss[(size_t)row * 16 + (col >> 6)] = ss;
    }
};
template <class RowEpi> __device__ __forceinline__ void gemm_small(LAS unsigned char* L, const bf16_t* A, const bf16_t* Bt, int N, int K, const RowEpi& E, int tid, int lane, int wave) {
    const int l15 = lane & 15, lq = lane >> 4;
    const int nblk = 16 * (N >> 6), kslice = K >> 3, nks = kslice >> 5;
    for (int blk = blockIdx.x; blk < nblk; blk += gridDim.x) {
        const int row0 = (blk & 15) * 64, col0 = (blk >> 4) * 64;
        f32x4 acc[4][4];
#pragma unroll
        for (int x = 0; x < 4; ++x)
#pragma unroll
            for (int y = 0; y < 4; ++y) acc[x][y] = (f32x4){0.f, 0.f, 0.f, 0.f};
        const bf16_t* ap = A + (size_t)(row0 + l15) * K + wave * kslice + 8 * lq;
        const bf16_t* bp = Bt + (size_t)(col0 + l15) * K + wave * kslice + 8 * lq;
#pragma unroll 4
        for (int ks = 0; ks < nks; ++ks) {
            bf16x8 xf[4], yf[4];
#pragma unroll
            for (int x = 0; x < 4; ++x) xf[x] = *(const bf16x8*)(ap + (size_t)(16 * x) * K + ks * 32);
#pragma unroll
            for (int y = 0; y < 4; ++y) yf[y] = *(const bf16x8*)(bp + (size_t)(16 * y) * K + ks * 32);
#pragma unroll
            for (int x = 0; x < 4; ++x)
#pragma unroll
                for (int y = 0; y < 4; ++y) acc[x][y] = MFMA16(yf[y], xf[x], acc[x][y]);
        }
        __syncthreads();
        LAS float* red = (LAS float*)L + wave * 4352;
#pragma unroll
        for (int x = 0; x < 4; ++x)
#pragma unroll
            for (int y = 0; y < 4; ++y) *(LAS f32x4*)(red + (16 * x + l15) * 68 + 16 * y + 4 * lq) = acc[x][y];
        __syncthreads();
        const int r = tid >> 3, c8 = (tid & 7) * 8;
        f32x4 v0 = (f32x4){0.f, 0.f, 0.f, 0.f}, v1 = v0;
#pragma unroll
        for (int w = 0; w < 8; ++w) { const LAS float* q = (const LAS float*)L + w * 4352 + r * 68 + c8; v0 += *(const LAS f32x4*)q; v1 += *(const LAS f32x4*)(q + 4); }
        E(NP + row0 + r, col0 + c8, v0, v1, tid);
    }
    __syncthreads();
}

struct Params {
    const float* in[30];
    float* out;
    unsigned char* ws;
    float inv[96];
    int ph_lo, ph_hi, pmask, pad;
};

template <class T> __device__ __forceinline__ T* opq(T* p) { asm volatile("" : "+s"(p)); return p; }

struct SrcBf16 { const bf16_t* p; size_t pitch;
    __device__ __forceinline__ u32x4 operator()(int r, int cq) const { return *(const u32x4*)(p + (size_t)r * pitch + cq * 8); } };
struct SrcBf16Z { const bf16_t* p; size_t pitch; int zero_below;
    __device__ __forceinline__ u32x4 operator()(int r, int cq) const { if (r < zero_below) return (u32x4){0u, 0u, 0u, 0u}; return *(const u32x4*)(p + (size_t)r * pitch + cq * 8); } };
struct SrcF32 { const float* p; size_t pitch;
    __device__ __forceinline__ u32x4 operator()(int r, int cq) const { const f32x4* q = (const f32x4*)(p + (size_t)r * pitch + cq * 8); return pack8(q[0], q[1]); } };
struct SrcBf16Scaled { const bf16_t* p; size_t pitch; float lg2; int top;
    __device__ __forceinline__ u32x4 operator()(int r, int cq) const {
        const u32x4 v = *(const u32x4*)(p + (size_t)r * pitch + cq * 8); const float s = fexp2((float)(top - r) * lg2); u32x4 w;
#pragma unroll
        for (int e = 0; e < 4; ++e) w[e] = cvt_pk_bf16(bf2f(v[e] & 0xffffu) * s, bf2f(v[e] >> 16) * s);
        return w; } };
struct SrcTail { const bf16_t* n;
    __device__ __forceinline__ u32x4 operator()(int r, int cq) const { u32x4 v = (u32x4){0u, 0u, 0u, 0u}; if (r < 8) v = *(const u32x4*)(n + (size_t)r * QKVW + cq * 8); return v; } };

template <int R, int C, class Src> __device__ __forceinline__ void stage_n(LAS unsigned char* dst, int pitchB, const Src& S, int tid, int roff = 0) {
    constexpr int CQ = C / 8, N = R * CQ;
#pragma unroll
    for (int it0 = 0; it0 < N; it0 += 512) { const int it = it0 + tid;
        if ((N % 512 == 0) || it < N) { const int r = it / CQ, cq = it % CQ; *(LAS u32x4*)(dst + (r + roff) * pitchB + cq * 16) = S(r, cq); } }
}
template <int R, int C, class Src> __device__ __forceinline__ void stage_t(LAS unsigned char* dst, int pitchB, const Src& S, int tid, int roff = 0) {
    constexpr int RP = R / 2, CQ = C / 8, N = RP * CQ;
#pragma unroll
    for (int it0 = 0; it0 < N; it0 += 512) { const int it = it0 + tid;
        if ((N % 512 == 0) || it < N) { const int rp = it % RP, cq = it / RP; const u32x4 a = S(2 * rp, cq), b = S(2 * rp + 1, cq);
            LAS unsigned char* d = dst + (cq * 8) * pitchB + rp * 4 + roff * 2;
#pragma unroll
            for (int e = 0; e < 4; ++e) {
                *(LAS unsigned*)(d + (2 * e) * pitchB) = (a[e] & 0xffffu) | (b[e] << 16);
                *(LAS unsigned*)(d + (2 * e + 1) * pitchB) = (a[e] >> 16) | (b[e] & 0xffff0000u); } } }
}

__device__ __forceinline__ int next_item(unsigned* ctr, LAS unsigned char* L) {
    __syncthreads();
    if (threadIdx.x == 0) *(LAS int*)(L + SLOT_OFF) = (int)__hip_atomic_fetch_add(ctr, 1u, __ATOMIC_RELAXED, __HIP_MEMORY_SCOPE_AGENT);
    __syncthreads();
    return *(LAS int*)(L + SLOT_OFF);
}

#define XB_TMO      128
#define XB_XCNT(j)  (256  + 64 * (j))
#define XB_XSUB(j)  (1280 + 64 * (j))
#define XB_XGEN(j)  (2304 + 64 * (j))
#define XB_TOP      3328
#define XB_TOPGEN   3392
#define XCD_BAR_WORDS 3456
#define XB_SPIN_CAP (1u << 18)
__device__ __forceinline__ unsigned xb_ld(unsigned* p)              { return __hip_atomic_load(p, __ATOMIC_RELAXED, __HIP_MEMORY_SCOPE_AGENT); }
__device__ __forceinline__ unsigned xb_add(unsigned* p, unsigned v) { return __hip_atomic_fetch_add(p, v, __ATOMIC_RELAXED, __HIP_MEMORY_SCOPE_AGENT); }
__device__ __forceinline__ unsigned xb_xcc_id() { return (unsigned)__builtin_amdgcn_s_getreg((3 << 11) | 20) & 0xFu; }
#define XB_SPIN(cond, bar) do { unsigned _sp = 0; while (cond) { __builtin_amdgcn_s_sleep(1); \
    if ((++_sp & 255u) == 0u) { if (xb_ld(&(bar)[XB_TMO])) break; if (_sp > XB_SPIN_CAP) { atomicAdd(&(bar)[XB_TMO], 1u); break; } } } } while (0)
struct XcdBarrier { unsigned* bar; unsigned x; volatile LAS unsigned* st; };
__device__ __forceinline__ XcdBarrier xcd_barrier_post(unsigned* bar, volatile LAS unsigned* st) {
    XcdBarrier b; b.bar = bar; b.x = xb_xcc_id(); b.st = st;
    if (threadIdx.x == 0) (void)xb_add(&bar[XB_XCNT(b.x)], 1u);
    return b;
}
__device__ __forceinline__ void xcd_barrier_complete(unsigned* bar, unsigned x, unsigned& nloc, unsigned& nx) {
    const unsigned G = gridDim.x * gridDim.y * gridDim.z;
    unsigned sum, cnt, mine, sp = 0u;
    for (;;) {
        sum = 0u; cnt = 0u; mine = 0u;
#pragma unroll
        for (unsigned j = 0; j < 16; ++j) { const unsigned c = xb_ld(&bar[XB_XCNT(j)]); sum += c; cnt += (c > 0u) ? 1u : 0u; mine = (j == x) ? c : mine; }
        if (sum == G) break;
        __builtin_amdgcn_s_sleep(1);
        if ((++sp & 255u) == 0u) { if (xb_ld(&bar[XB_TMO])) break; if (sp > XB_SPIN_CAP) { atomicAdd(&bar[XB_TMO], 1u); break; } }
    }
    nloc = mine > 0u ? mine : 1u; nx = cnt > 0u ? cnt : 1u;
}
__device__ __forceinline__ void xcd_barrier(const XcdBarrier& b) {
    asm volatile("s_waitcnt vmcnt(0)" ::: "memory");
    __syncthreads();
    if (threadIdx.x == 0) {
        unsigned* bar = b.bar;
        __builtin_amdgcn_s_waitcnt(0);
        unsigned nloc = b.st[0], nx = b.st[1];
        if (nloc == 0u) { xcd_barrier_complete(bar, b.x, nloc, nx); b.st[0] = nloc; b.st[1] = nx; }
        const unsigned old = xb_add(&bar[XB_XSUB(b.x)], 1u);
        const unsigned gen = old / nloc;
        if (old + 1u == (gen + 1u) * nloc) {
            __builtin_amdgcn_fence(__ATOMIC_RELEASE, "agent");
            asm volatile("s_waitcnt vmcnt(0)" ::: "memory");
            const unsigned og = xb_add(&bar[XB_TOP], 1u);
            const unsigned tg = og / nx;
            if (og + 1u == (tg + 1u) * nx) xb_add(&bar[XB_TOPGEN], 1u);
            else XB_SPIN(xb_ld(&bar[XB_TOPGEN]) == tg, bar);
            __builtin_amdgcn_fence(__ATOMIC_ACQUIRE, "agent");
            xb_add(&bar[XB_XGEN(b.x)], 1u);
            asm volatile("s_waitcnt vmcnt(0)" ::: "memory");
        } else {
            XB_SPIN(xb_ld(&bar[XB_XGEN(b.x)]) == gen, bar);
            __builtin_amdgcn_fence(__ATOMIC_ACQUIRE, "agent");
            asm volatile("s_waitcnt vmcnt(0)" ::: "memory");
        }
    }
    __syncthreads();
}

__device__ __forceinline__ void p0_transpose_item(const float* W, int K, int N, bf16_t* WT, int row_off, LAS float* scr, int item, int lane, const float* gk) {
    const int nblk = N / 32, kb = item / nblk, nb = item % nblk, k0 = 64 * kb, n0 = 32 * nb;
    float wv[32];
#pragma unroll
    for (int i = 0; i < 32; ++i) { const int kk = 2 * i + (lane >> 5); wv[i] = __builtin_nontemporal_load(W + (size_t)(k0 + kk) * N + n0 + (lane & 31)); }
    if (gk) {
#pragma unroll
        for (int i = 0; i < 32; ++i) wv[i] *= gk[k0 + 2 * i + (lane >> 5)]; }
#pragma unroll
    for (int i = 0; i < 32; ++i) { const int kk = 2 * i + (lane >> 5); scr[kk * 33 + (lane & 31)] = wv[i]; }
    asm volatile("s_waitcnt lgkmcnt(0)" ::: "memory");
    const int c = lane & 7;
#pragma unroll
    for (int j = 0; j < 4; ++j) { const int n = (lane >> 3) + 8 * j; const LAS float* s = scr + (8 * c) * 33 + n;
        u32x4 o; o.x = cvt_pk_bf16(s[0 * 33], s[1 * 33]); o.y = cvt_pk_bf16(s[2 * 33], s[3 * 33]); o.z = cvt_pk_bf16(s[4 * 33], s[5 * 33]); o.w = cvt_pk_bf16(s[6 * 33], s[7 * 33]);
        *(u32x4*)(WT + (size_t)(row_off + n0 + n) * K + k0 + 8 * c) = o; }
    asm volatile("s_waitcnt lgkmcnt(0)" ::: "memory");
}

__device__ __forceinline__ void phase_prologue(const Params& P, LAS unsigned char* L, int tid, int lane, int wave) {
    unsigned char* ws = opq(P.ws);
    LAS float* scr = (LAS float*)(L + wave * 16384);
    const int gw = blockIdx.x * 8 + wave, NGW = gridDim.x * 8;
    constexpr int I_IN = 16 * 160, I_OE = 32 * 32, I_QKV = 16 * 48, I_SQ = 16 * 32, I_UP = 16 * 128, I_DN = 64 * 32;
    constexpr int NITEMS = I_IN + I_OE + I_QKV + I_SQ + 8 * I_SQ + 2 * I_UP + 2 * I_DN;
    for (int it = gw; it < NITEMS; it += NGW) {
        int r = it; const float* src; bf16_t* dst; int K = 1024, N = 1024, roff = 0; const float* gk = nullptr;
        if (r < I_IN) { src = P.in[9]; N = 5120; dst = (bf16_t*)(ws + WS_WIN); gk = P.in[8]; }
        else if ((r -= I_IN) < I_OE) { src = P.in[14]; K = 2048; dst = (bf16_t*)(ws + WS_WOUTE); }
        else if ((r -= I_OE) < I_QKV) { src = P.in[15]; N = 1536; dst = (bf16_t*)(ws + WS_WQKV); gk = P.in[8] + DM; }
        else if ((r -= I_QKV) < I_SQ) { src = P.in[18]; dst = (bf16_t*)(ws + WS_WOUTO); }
        else if ((r -= I_SQ) < 8 * I_SQ) { const int w = r / I_SQ, l = w & 1, kind = w >> 1; r -= w * I_SQ;
            src = P.in[22 + kind] + (size_t)l * 1024 * 1024; roff = (kind == 2) ? 1024 : 0; if (kind == 0) gk = P.in[20] + l * DM;
            dst = (kind == 0) ? (bf16_t*)(ws + WS_WMQ + l * 2 * MiB) : (kind == 3) ? (bf16_t*)(ws + WS_WMO + l * 2 * MiB) : (bf16_t*)(ws + WS_WMKV + l * 4 * MiB); }
        else if ((r -= 8 * I_SQ) < 2 * I_UP) { const int l = r / I_UP; r -= l * I_UP; src = P.in[27] + (size_t)l * 1024 * 4096; N = 4096; dst = (bf16_t*)(ws + WS_WUP + l * 8 * MiB); gk = P.in[26] + l * DM; }
        else { r -= 2 * I_UP; const int l = r / I_DN; r -= l * I_DN; src = P.in[28] + (size_t)l * 1024 * 4096; K = 4096; dst = (bf16_t*)(ws + WS_WDOWN + l * 8 * MiB); }
        p0_transpose_item(src, K, N, dst, roff, scr, r, lane, gk);
    }
    {
        bf16_t* XN = (bf16_t*)(ws + WS_XN); float* rss = (float*)(ws + WS_RSS);
        for (int row = gw; row < NTOK; row += NGW) {
            const float* xr = (row < NP) ? P.in[0] + (size_t)row * DM : P.in[1] + (size_t)(row - NP) * DM;
            float ss = 0.f;
#pragma unroll
            for (int j = 0; j < 2; ++j) { const int c = 8 * lane + 512 * j;
                const f32x4 a = __builtin_nontemporal_load((const f32x4*)(xr + c)), b = __builtin_nontemporal_load((const f32x4*)(xr + c + 4));
                ss += (a[0] * a[0] + a[1] * a[1]) + (a[2] * a[2] + a[3] * a[3]) + (b[0] * b[0] + b[1] * b[1]) + (b[2] * b[2] + b[3] * b[3]);
                *(u32x4*)(XN + (size_t)row * DM + c) = pack8(a, b); }
            ss = wave_sum(ss);
            if (lane < 16) rss[(size_t)row * 16 + lane] = (lane == 0) ? ss : 0.f;
        }
    }
    {
        const float* mem = P.in[7]; const float* g = P.in[21];
        for (int row = gw; row < 2048; row += NGW) {
            const float* xr = mem + (size_t)row * DM; f32x4 v[4]; float ss = 0.f;
#pragma unroll
            for (int j = 0; j < 2; ++j) { const int c = 8 * lane + 512 * j; v[2 * j] = *(const f32x4*)(xr + c); v[2 * j + 1] = *(const f32x4*)(xr + c + 4);
                const f32x4 a = v[2 * j], b = v[2 * j + 1];
                ss += (a[0] * a[0] + a[1] * a[1]) + (a[2] * a[2] + a[3] * a[3]) + (b[0] * b[0] + b[1] * b[1]) + (b[2] * b[2] + b[3] * b[3]); }
            const float r = 1.0f / sqrtf(wave_sum(ss) * (1.0f / 1024.0f) + EPS);
#pragma unroll
            for (int l = 0; l < 2; ++l) { bf16_t* MN = (bf16_t*)(ws + WS_MN + l * 4 * MiB);
#pragma unroll
                for (int j = 0; j < 2; ++j) { const int c = 8 * lane + 512 * j; const f32x4 ga = *(const f32x4*)(g + l * DM + c), gb = *(const f32x4*)(g + l * DM + c + 4);
                    *(u32x4*)(MN + (size_t)row * DM + c) = pack8(v[2 * j] * r * ga, v[2 * j + 1] * r * gb); } }
        }
    }
    {
        f32x2* rotR = (f32x2*)(ws + WS_ROTR); f32x2* rotC = (f32x2*)(ws + WS_ROTC);
        const int gt = blockIdx.x * 512 + tid, NGT = gridDim.x * 512;
        for (int i = gt; i < 2056 * 96; i += NGT) {
            const int pi = i / 96, j = i % 96; const int pos = pi < 2048 ? pi : 16384 + pi - 2048;
            const float inv = P.inv[j];
            const float ang = (float)pos * inv;
            double rev = (double)ang * 0.15915494309189535; rev -= rint(rev);
            const float c = __builtin_amdgcn_cosf((float)rev), s = __builtin_amdgcn_sinf((float)rev);
            if (j < 64) rotR[pi * 64 + j] = (f32x2){c, s}; else rotC[pi * 32 + (j - 64)] = (f32x2){c, s};
        }
    }
}

__device__ __forceinline__ void phase_rowpass_a(const Params& P, int lane, int wave) {
    unsigned char* ws = opq(P.ws); bf16_t* Z = (bf16_t*)(ws + WS_Z); const f32x2* rotR = (const f32x2*)(ws + WS_ROTR);
    const float* lng = P.in[10]; const float* lnb = P.in[11]; float* sguv = opq(P.out) + O_SGUV;
    const int gw = blockIdx.x * 8 + wave, NGW = gridDim.x * 8;
    for (int row = gw; row < NTOK; row += NGW) {
        bf16_t* zr = Z + (size_t)row * ZW;
        float v[16]; float s = 0.f;
#pragma unroll
        for (int j = 0; j < 2; ++j) { const u32x4 w = *(const u32x4*)(zr + 1024 + 8 * lane + 512 * j);
#pragma unroll
            for (int e = 0; e < 4; ++e) { v[8 * j + 2 * e] = bf2f(w[e] & 0xffffu); v[8 * j + 2 * e + 1] = bf2f(w[e] >> 16); } }
#pragma unroll
        for (int e = 0; e < 16; ++e) s += v[e];
        const float mean = wave_sum(s) * (1.0f / 1024.0f); float q = 0.f;
#pragma unroll
        for (int e = 0; e < 16; ++e) { v[e] -= mean; q += v[e] * v[e]; }
        const float rstd = 1.0f / sqrtf(wave_sum(q) * (1.0f / 1024.0f) + EPS);
#pragma unroll
        for (int j = 0; j < 2; ++j) { const int c = 8 * lane + 512 * j;
            const f32x4 ga = *(const f32x4*)(lng + c), gb = *(const f32x4*)(lng + c + 4), ba = *(const f32x4*)(lnb + c), bb = *(const f32x4*)(lnb + c + 4);
            f32x4 a, b;
#pragma unroll
            for (int e = 0; e < 4; ++e) { a[e] = v[8 * j + e] * rstd * ga[e] + ba[e]; b[e] = v[8 * j + 4 + e] * rstd * gb[e] + bb[e]; }
            *(u32x4*)(zr + 1024 + c) = pack8(a, b);
            if (row >= NP) { float* o = sguv + (size_t)(row - NP) * 1024 + c; *(f32x4*)o = a; *(f32x4*)(o + 4) = b; } }
        const int pi = row < NP ? (row & 2047) : 2048 + ((row - NP) & 7);
        const f32x2 cs = rotR[pi * 64 + lane];
#pragma unroll
        for (int hh = 0; hh < 8; ++hh) { bf16_t* p = zr + 2048 + hh * 128 + lane; const float a = bf2f(p[0]), b = bf2f(p[64]); const float sc = hh >= 4 ? 0.08838834764831845f : 1.0f;
            const float ra = (a * cs.x - b * cs.y) * sc, rb = (a * cs.y + b * cs.x) * sc; const unsigned w = cvt_pk_bf16(ra, rb); p[0] = (bf16_t)(w & 0xffffu); p[64] = (bf16_t)(w >> 16); }
    }
}

__device__ __forceinline__ void phase_rowpass_b(const Params& P, int lane, int wave) {
    unsigned char* ws = opq(P.ws); bf16_t* QKV = (bf16_t*)(ws + WS_Z); const f32x2* rotC = (const f32x2*)(ws + WS_ROTC);
    float* wkp = opq(P.out) + O_WKP; float* wvp = opq(P.out) + O_WVP;
    const int gw = blockIdx.x * 8 + wave, NGW = gridDim.x * 8;
    for (int row = gw; row < NTOK; row += NGW) {
        bf16_t* zr = QKV + (size_t)row * QKVW;
        const int pi = row < NP ? (row & 2047) : 2048 + ((row - NP) & 7);
        const bool tail = (row < NP) && ((row & 2047) >= 1920);
        const int b = row >> 11, w = (row & 2047) - 1920;
#pragma unroll
        for (int pass = 0; pass < 2; ++pass) { const int task = lane + 64 * pass;
            if (task < 80) { const int hd = task >> 2, j0 = (task & 3) * 8;
                bf16_t* p = zr + hd * 64 + j0; const u32x4 va = *(const u32x4*)p, vb = *(const u32x4*)(p + 32);
                const f32x4* cs = (const f32x4*)(rotC + pi * 32 + j0);
                f32x4 ra0, ra1, rb0, rb1; u32x4 oa, ob;
#pragma unroll
                for (int e = 0; e < 4; ++e) { const f32x4 c2 = cs[e];
                    const float a0 = bf2f(va[e] & 0xffffu), a1 = bf2f(va[e] >> 16), b0 = bf2f(vb[e] & 0xffffu), b1 = bf2f(vb[e] >> 16);
                    const float xa0 = a0 * c2[0] - b0 * c2[1], xb0 = a0 * c2[1] + b0 * c2[0], xa1 = a1 * c2[2] - b1 * c2[3], xb1 = a1 * c2[3] + b1 * c2[2];
                    oa[e] = cvt_pk_bf16(xa0, xa1); ob[e] = cvt_pk_bf16(xb0, xb1);
                    if (e < 2) { ra0[2 * e] = xa0; ra0[2 * e + 1] = xa1; rb0[2 * e] = xb0; rb0[2 * e + 1] = xb1; } else { ra1[2 * e - 4] = xa0; ra1[2 * e - 3] = xa1; rb1[2 * e - 4] = xb0; rb1[2 * e - 3] = xb1; } }
                *(u32x4*)p = oa; *(u32x4*)(p + 32) = ob;
                if (tail && hd >= 16) { float* o = wkp + ((size_t)(b * 128 + w) * 4 + (hd - 16)) * 64 + j0; *(f32x4*)o = ra0; *(f32x4*)(o + 4) = ra1; *(f32x4*)(o + 32) = rb0; *(f32x4*)(o + 36) = rb1; } } }
        if (tail) { const u32x2 v = *(const u32x2*)(zr + 1280 + 4 * lane);
            *(f32x4*)(wvp + (size_t)(b * 128 + w) * 256 + 4 * lane) = (f32x4){bf2f(v.x & 0xffffu), bf2f(v.x >> 16), bf2f(v.y & 0xffffu), bf2f(v.y >> 16)}; }
    }
}

__device__ __forceinline__ void unit_scan(const Params& P, LAS unsigned char* L, int item, int tid, int lane, int wave) {
    unsigned char* ws = opq(P.ws); const bf16_t* Z = (const bf16_t*)(ws + WS_Z); bf16_t* ST = (bf16_t*)(ws + WS_ST); float* retp = opq(P.out) + O_RETP;
    const int es = item & 3, h = (item >> 2) & 3, b = item >> 4;
    const int l15 = lane & 15, lq = lane >> 4;
    LAS unsigned char* KT = L; LAS unsigned char* VT = L + 34816;
    const float lg2 = log2f(1.0f - fexp2(-5.0f - (float)h)); const float cd = fexp2(128.0f * lg2);
    f32x4 acc[4];
#pragma unroll
    for (int x = 0; x < 4; ++x) acc[x] = (f32x4){0.f, 0.f, 0.f, 0.f};
    for (int c = 0; c < 16; ++c) {
        const size_t row0 = (size_t)b * SEQ + c * 128;
        bf16_t* st = ST + ((size_t)((b * 16 + c) * 4 + h)) * 32768;
#pragma unroll
        for (int x = 0; x < 4; ++x) { const int e = es * 64 + 16 * x + l15, d = 16 * wave + 4 * lq; u32x2 w; w.x = cvt_pk_bf16(acc[x][0], acc[x][1]); w.y = cvt_pk_bf16(acc[x][2], acc[x][3]); *(u32x2*)(st + e * 128 + d) = w; }
        __syncthreads();
        stage_t<128, 128>(KT, 272, SrcBf16Scaled{Z + row0 * ZW + 2560 + h * 128, (size_t)ZW, lg2, 127}, tid);
        stage_t<128, 64>(VT, 272, SrcBf16{Z + row0 * ZW + 3072 + h * 256 + es * 64, (size_t)ZW}, tid);
        __syncthreads();
#pragma unroll
        for (int x = 0; x < 4; ++x) acc[x] = acc[x] * cd;
#pragma unroll
        for (int ks = 0; ks < 4; ++ks) { const int kb = (ks * 32 + 8 * lq) * 2; const bf16x8 yf = frag(KT, 16 * wave + l15, 272, kb);
#pragma unroll
            for (int x = 0; x < 4; ++x) acc[x] = MFMA16(yf, frag(VT, 16 * x + l15, 272, kb), acc[x]); }
    }
#pragma unroll
    for (int x = 0; x < 4; ++x) { const int e = es * 64 + 16 * x + l15;
#pragma unroll
        for (int r = 0; r < 4; ++r) { const int d = 16 * wave + 4 * lq + r; retp[((size_t)(b * 4 + h) * 128 + d) * 256 + e] = acc[x][r]; } }
}

__device__ __forceinline__ void unit_sgu(const Params& P, LAS unsigned char* L, int item, int tid, int lane, int wave) {
    unsigned char* ws = opq(P.ws); const bf16_t* Z = (const bf16_t*)(ws + WS_Z); bf16_t* AB = (bf16_t*)(ws + WS_AB);
    const int g = item & 3, c = (item >> 2) & 15, b = item >> 6;
    const int l15 = lane & 15, lq = lane >> 4;
    const size_t row0 = (size_t)b * SEQ + c * 128;
    LAS unsigned char* WL = L; LAS unsigned char* VT = L + 34816;
    const float* wsp = P.in[12] + (size_t)g * 128 * 128;
#pragma unroll
    for (int k = 0; k < 4; ++k) { const int it = tid + 512 * k, t = it >> 4, sq = it & 15; const f32x4* q = (const f32x4*)(wsp + t * 128 + sq * 8); f32x4 a = q[0], bb = q[1];
#pragma unroll
        for (int e = 0; e < 4; ++e) { if (sq * 8 + e > t) a[e] = 0.f; if (sq * 8 + 4 + e > t) bb[e] = 0.f; }
        *(LAS u32x4*)(WL + t * 272 + sq * 16) = pack8(a, bb); }
    stage_t<128, 256>(VT, 272, SrcBf16{Z + row0 * ZW + 1024 + g * 256, (size_t)ZW}, tid);
    __syncthreads();
    f32x4 acc[8][2];
#pragma unroll
    for (int x = 0; x < 8; ++x) { acc[x][0] = (f32x4){0.f, 0.f, 0.f, 0.f}; acc[x][1] = (f32x4){0.f, 0.f, 0.f, 0.f}; }
#pragma unroll
    for (int ks = 0; ks < 4; ++ks) { const int kb = (ks * 32 + 8 * lq) * 2;
        const bf16x8 y0 = frag(VT, 32 * wave + l15, 272, kb), y1 = frag(VT, 32 * wave + 16 + l15, 272, kb);
#pragma unroll
        for (int x = 0; x < 8; ++x) if (ks * 32 <= x * 16 + 15) { const bf16x8 xf = frag(WL, 16 * x + l15, 272, kb); acc[x][0] = MFMA16(y0, xf, acc[x][0]); acc[x][1] = MFMA16(y1, xf, acc[x][1]); } }
    const float* bsp = P.in[13] + g * 128;
#pragma unroll
    for (int x = 0; x < 8; ++x) { const int t = 16 * x + l15; const float bs = bsp[t];
#pragma unroll
        for (int n = 0; n < 2; ++n) { const int d = 32 * wave + 16 * n + 4 * lq;
            const u32x2 u = *(const u32x2*)(Z + (row0 + t) * ZW + g * 256 + d);
            u32x2 w; w.x = cvt_pk_bf16(bf2f(u.x & 0xffffu) * (acc[x][n][0] + bs), bf2f(u.x >> 16) * (acc[x][n][1] + bs));
            w.y = cvt_pk_bf16(bf2f(u.y & 0xffffu) * (acc[x][n][2] + bs), bf2f(u.y >> 16) * (acc[x][n][3] + bs));
            *(u32x2*)(AB + (row0 + t) * 2048 + g * 256 + d) = w; } }
}

__device__ __forceinline__ void unit_sgu_sample(const Params& P, int bs, int tid) {
    unsigned char* ws = opq(P.ws); const bf16_t* Z = (const bf16_t*)(ws + WS_Z); bf16_t* AB = (bf16_t*)(ws + WS_AB);
    const size_t row0 = (size_t)NP + bs * 8; const int col = 2 * tid, g = col >> 8;
    const float* wsp = P.in[12] + (size_t)g * 128 * 128; const float* bsp = P.in[13] + g * 128;
    float v0[8], v1[8];
#pragma unroll
    for (int s = 0; s < 8; ++s) { const unsigned w = *(const unsigned*)(Z + (row0 + s) * ZW + 1024 + col); v0[s] = bf2f(w & 0xffffu); v1[s] = bf2f(w >> 16); }
#pragma unroll
    for (int t = 0; t < 8; ++t) { float m0 = bsp[t], m1 = m0;
#pragma unroll
        for (int s = 0; s <= t; ++s) { const float w = wsp[t * 128 + s]; m0 += w * v0[s]; m1 += w * v1[s]; }
        const unsigned u = *(const unsigned*)(Z + (row0 + t) * ZW + col);
        *(unsigned*)(AB + (row0 + t) * 2048 + col) = cvt_pk_bf16(bf2f(u & 0xffffu) * m0, bf2f(u >> 16) * m1); }
}

__device__ __forceinline__ void unit_ret_sample(const Params& P, LAS unsigned char* L, int item, int tid, int lane, int wave) {
    unsigned char* ws = opq(P.ws); const bf16_t* Z = (const bf16_t*)(ws + WS_Z); bf16_t* AB = (bf16_t*)(ws + WS_AB);
    asm volatile("" : "+v"(tid));
    const int h = item & 3, bs = item >> 2; const size_t row0 = (size_t)NP + bs * 8;
    const float lg2 = log2f(1.0f - fexp2(-5.0f - (float)h)); const float cd = fexp2(8.0f * lg2);
    LAS float* qs = (LAS float*)L;
    LAS float* kz = (LAS float*)(L + 4096);
    LAS float* kr = (LAS float*)(L + 8192);
    LAS float* sc = (LAS float*)(L + 12288);
    LAS float* po = (LAS float*)(L + 12544);
    LAS float* red = (LAS float*)(L + 12544 + 65536);
    for (int it = tid; it < 2048; it += 512) { const int qk = it >> 10, r = (it >> 7) & 7, d = it & 127;
        const float v = bf2f(Z[(row0 + r) * ZW + 2048 + qk * 512 + h * 128 + d]);
        if (qk == 0) qs[d * 8 + r] = v; else { kr[r * 128 + d] = v; kz[d * 8 + r] = v * fexp2((float)(7 - r) * lg2); } }
    __syncthreads();
    if (tid < 64) { const int i = tid >> 3, j = tid & 7; float s = 0.f;
        if (j <= i) { for (int d = 0; d < 128; ++d) s += qs[d * 8 + i] * kr[j * 128 + d]; s *= fexp2((float)(i - j) * lg2); }
        sc[i * 8 + j] = s; }
    const int e = tid & 255, dh = tid >> 8;
    float vj[8];
#pragma unroll
    for (int j = 0; j < 8; ++j) vj[j] = bf2f(Z[(row0 + j) * ZW + 3072 + h * 256 + e]);
    {
        const int e4 = (tid & 63) * 4, ds = tid >> 6;
        f32x4 vj4[8];
#pragma unroll
        for (int j = 0; j < 8; ++j) { const u32x2 w = *(const u32x2*)(Z + (row0 + j) * ZW + 3072 + h * 256 + e4); vj4[j] = (f32x4){bf2f(w.x & 0xffffu), bf2f(w.x >> 16), bf2f(w.y & 0xffffu), bf2f(w.y >> 16)}; }
        const float* S0 = P.in[2] + ((size_t)(bs * 4 + h) * 128 + ds * 16) * 256 + e4; float* S1 = opq(P.out) + O_RETS + ((size_t)(bs * 4 + h) * 128 + ds * 16) * 256 + e4;
        f32x4 pacc[8];
#pragma unroll
        for (int i = 0; i < 8; ++i) pacc[i] = (f32x4){0.f, 0.f, 0.f, 0.f};
#pragma unroll 4
        for (int dd = 0; dd < 16; ++dd) { const int d = ds * 16 + dd; const f32x4 sv = __builtin_nontemporal_load((const f32x4*)(S0 + (size_t)dd * 256));
            const f32x4 q0 = *(const LAS f32x4*)(qs + d * 8), q1 = *(const LAS f32x4*)(qs + d * 8 + 4), k0 = *(const LAS f32x4*)(kz + d * 8), k1 = *(const LAS f32x4*)(kz + d * 8 + 4);
            f32x4 sn = sv * cd;
#pragma unroll
            for (int i = 0; i < 4; ++i) { pacc[i] += sv * q0[i]; pacc[4 + i] += sv * q1[i]; sn += vj4[i] * k0[i] + vj4[4 + i] * k1[i]; }
            __builtin_nontemporal_store(sn, (f32x4*)(S1 + (size_t)dd * 256)); }
#pragma unroll
        for (int i = 0; i < 8; ++i) *(LAS f32x4*)(po + (ds * 8 + i) * 256 + e4) = pacc[i];
    }
    __syncthreads();
    float o[4]; float ssq[4];
#pragma unroll
    for (int ii = 0; ii < 4; ++ii) { const int i = dh * 4 + ii; float a = 0.f;
#pragma unroll
        for (int ds = 0; ds < 8; ++ds) a += po[(ds * 8 + i) * 256 + e];
        a *= fexp2((float)(i + 1) * lg2);
#pragma unroll
        for (int j = 0; j < 8; ++j) if (j <= i) a += sc[i * 8 + j] * vj[j];
        o[ii] = a; ssq[ii] = wave_sum(a * a); }
    if (lane == 0) {
#pragma unroll
        for (int ii = 0; ii < 4; ++ii) red[wave * 4 + ii] = ssq[ii]; }
    __syncthreads();
#pragma unroll
    for (int ii = 0; ii < 4; ++ii) { const int i = dh * 4 + ii; const int w0 = dh * 4;
        const float tot = (red[(w0 + 0) * 4 + ii] + red[(w0 + 1) * 4 + ii]) + (red[(w0 + 2) * 4 + ii] + red[(w0 + 3) * 4 + ii]);
        const float rstd = 1.0f / sqrtf(tot * (1.0f / 256.0f) + EPS);
        const float gate = bf2f(Z[(row0 + i) * ZW + 4096 + h * 256 + e]);
        AB[(row0 + i) * 2048 + 1024 + h * 256 + e] = (bf16_t)(cvt_pk_bf16(o[ii] * rstd * silu(gate), 0.f) & 0xffffu); }
}

__device__ __forceinline__ void unit_ret_out(const Params& P, LAS unsigned char* L, int item, int tid, int lane, int wave) {
    unsigned char* ws = opq(P.ws); const bf16_t* Z = (const bf16_t*)(ws + WS_Z); bf16_t* AB = (bf16_t*)(ws + WS_AB); const bf16_t* ST = (const bf16_t*)(ws + WS_ST);
    const int h = item & 3, c = (item >> 2) & 15, b = item >> 6;
    const int l15 = lane & 15, lq = lane >> 4;
    const size_t row0 = (size_t)b * SEQ + c * 128;
    const float lg2 = log2f(1.0f - fexp2(-5.0f - (float)h));
    LAS unsigned char* QL = L; LAS unsigned char* KL = L + 34816; LAS unsigned char* VT = L + 69632; LAS float* RED = (LAS float*)(L + 139264);
    stage_n<128, 128>(QL, 272, SrcBf16{Z + row0 * ZW + 2048 + h * 128, (size_t)ZW}, tid);
    stage_n<128, 128>(KL, 272, SrcBf16{Z + row0 * ZW + 2560 + h * 128, (size_t)ZW}, tid);
    stage_t<128, 256>(VT, 272, SrcBf16{Z + row0 * ZW + 3072 + h * 256, (size_t)ZW}, tid);
    __syncthreads();
    {
        f32x4 sc[8];
#pragma unroll
        for (int x = 0; x < 8; ++x) sc[x] = (f32x4){0.f, 0.f, 0.f, 0.f};
#pragma unroll
        for (int ks = 0; ks < 4; ++ks) { const int kb = (ks * 32 + 8 * lq) * 2; const bf16x8 yf = frag(KL, 16 * wave + l15, 272, kb);
#pragma unroll
            for (int x = 0; x < 8; ++x) if (x >= wave) sc[x] = MFMA16(yf, frag(QL, 16 * x + l15, 272, kb), sc[x]); }
        __syncthreads();
#pragma unroll
        for (int x = 0; x < 8; ++x) { const int i = 16 * x + l15, j0 = 16 * wave + 4 * lq; float p[4];
#pragma unroll
            for (int r = 0; r < 4; ++r) { const int j = j0 + r; p[r] = (i >= j) ? sc[x][r] * fexp2((float)(i - j) * lg2) : 0.f; }
            u32x2 w; w.x = cvt_pk_bf16(p[0], p[1]); w.y = cvt_pk_bf16(p[2], p[3]); *(LAS u32x2*)(KL + i * 272 + j0 * 2) = w; }
    }
    f32x4 acc[8][2];
#pragma unroll
    for (int x = 0; x < 8; ++x) { acc[x][0] = (f32x4){0.f, 0.f, 0.f, 0.f}; acc[x][1] = (f32x4){0.f, 0.f, 0.f, 0.f}; }
    {
        const bf16_t* st = ST + ((size_t)((b * 16 + c) * 4 + h)) * 32768;
        bf16x8 yg[4][2];
#pragma unroll
        for (int ks = 0; ks < 4; ++ks) { yg[ks][0] = *(const bf16x8*)(st + (32 * wave + l15) * 128 + ks * 32 + 8 * lq); yg[ks][1] = *(const bf16x8*)(st + (32 * wave + 16 + l15) * 128 + ks * 32 + 8 * lq); }
#pragma unroll
        for (int ks = 0; ks < 4; ++ks) { const int kb = (ks * 32 + 8 * lq) * 2;
#pragma unroll
            for (int x = 0; x < 8; ++x) { const bf16x8 xf = frag(QL, 16 * x + l15, 272, kb); acc[x][0] = MFMA16(yg[ks][0], xf, acc[x][0]); acc[x][1] = MFMA16(yg[ks][1], xf, acc[x][1]); } }
#pragma unroll
        for (int x = 0; x < 8; ++x) { const float xi = fexp2((float)(16 * x + l15 + 1) * lg2); acc[x][0] = acc[x][0] * xi; acc[x][1] = acc[x][1] * xi; }
    }
    __syncthreads();
#pragma unroll
    for (int ks = 0; ks < 4; ++ks) { const int kb = (ks * 32 + 8 * lq) * 2;
        const bf16x8 y0 = frag(VT, 32 * wave + l15, 272, kb), y1 = frag(VT, 32 * wave + 16 + l15, 272, kb);
#pragma unroll
        for (int x = 0; x < 8; ++x) if (ks * 32 <= x * 16 + 15) { const bf16x8 xf = frag(KL, 16 * x + l15, 272, kb); acc[x][0] = MFMA16(y0, xf, acc[x][0]); acc[x][1] = MFMA16(y1, xf, acc[x][1]); } }
#pragma unroll
    for (int x = 0; x < 8; ++x) { float ss = 0.f;
#pragma unroll
        for (int n = 0; n < 2; ++n)
#pragma unroll
            for (int r = 0; r < 4; ++r) ss += acc[x][n][r] * acc[x][n][r];
        ss += __shfl_xor(ss, 16); ss += __shfl_xor(ss, 32);
        if (lq == 0) RED[wave * 128 + 16 * x + l15] = ss; }
    __syncthreads();
#pragma unroll
    for (int x = 0; x < 8; ++x) { const int i = 16 * x + l15; float tot = 0.f;
#pragma unroll
        for (int w = 0; w < 8; ++w) tot += RED[w * 128 + i];
        const float rstd = 1.0f / sqrtf(tot * (1.0f / 256.0f) + EPS);
#pragma unroll
        for (int n = 0; n < 2; ++n) { const int e = 32 * wave + 16 * n + 4 * lq;
            const u32x2 gt = *(const u32x2*)(Z + (row0 + i) * ZW + 4096 + h * 256 + e);
            u32x2 w; w.x = cvt_pk_bf16(acc[x][n][0] * rstd * silu(bf2f(gt.x & 0xffffu)), acc[x][n][1] * rstd * silu(bf2f(gt.x >> 16)));
            w.y = cvt_pk_bf16(acc[x][n][2] * rstd * silu(bf2f(gt.y & 0xffffu)), acc[x][n][3] * rstd * silu(bf2f(gt.y >> 16)));
            *(u32x2*)(AB + (row0 + i) * 2048 + 1024 + h * 256 + e) = w; } }
}

template <int NKT> __device__ __forceinline__ float softmax_rows(f32x4 (&sc)[NKT], LAS unsigned char* PL, int l15, int lq, float extra) {
    float m = extra;
#pragma unroll
    for (int y = 0; y < NKT; ++y) m = fmaxf(m, fmaxf(fmaxf(sc[y][0], sc[y][1]), fmaxf(sc[y][2], sc[y][3])));
    m = fmaxf(m, __shfl_xor(m, 16)); m = fmaxf(m, __shfl_xor(m, 32));
    float s = 0.f;
#pragma unroll
    for (int y = 0; y < NKT; ++y) { float p[4];
#pragma unroll
        for (int r = 0; r < 4; ++r) { p[r] = fexp(sc[y][r] - m); s += p[r]; }
        u32x2 w; w.x = cvt_pk_bf16(p[0], p[1]); w.y = cvt_pk_bf16(p[2], p[3]); *(LAS u32x2*)(PL + l15 * 528 + (16 * y + 4 * lq) * 2) = w; }
    s += __shfl_xor(s, 16); s += __shfl_xor(s, 32);
    s += fexp(extra - m);
    return 1.0f / s;
}

template <bool SAMPLE> __device__ __forceinline__ void unit_cross(const Params& P, LAS unsigned char* L, int layer, int item, int tid, int lane, int wave) {
    unsigned char* ws = opq(P.ws); const bf16_t* Q = (const bf16_t*)(ws + WS_Q); bf16_t* O = (bf16_t*)(ws + WS_AB);
    const int l15 = lane & 15, lq = lane >> 4;
    int h, tok; bool active, store_ok;
    const bf16_t* kvb = nullptr; const float* kf = nullptr; const float* vf = nullptr;
    if (SAMPLE) { h = item & 3; const int bs = item >> 2; tok = NP + bs * 8 + (l15 & 7); active = (wave == 0); store_ok = l15 < 8;
        kf = P.in[5] + ((size_t)(layer * 128 + bs) * 256) * 1024 + h * 256; vf = P.in[6] + ((size_t)(layer * 128 + bs) * 256) * 1024 + h * 256; }
    else { h = item & 3; const int rt = (item >> 2) & 15, b = item >> 6; tok = b * SEQ + rt * 128 + 16 * wave + l15; active = true; store_ok = true;
        kvb = (const bf16_t*)(ws + WS_MKV + layer * 8 * MiB) + (size_t)(b * 256) * 2048 + h * 256; }
    LAS unsigned char* KL = L; LAS unsigned char* PL = L + 69632 + wave * 8448;
    f32x4 sc[16];
#pragma unroll
    for (int y = 0; y < 16; ++y) sc[y] = (f32x4){0.f, 0.f, 0.f, 0.f};
    bf16x8 qf[8];
#pragma unroll
    for (int k = 0; k < 8; ++k) qf[k] = *(const bf16x8*)(Q + (size_t)tok * DM + h * 256 + k * 32 + 8 * lq);
#pragma unroll
    for (int dh = 0; dh < 2; ++dh) {
        if (SAMPLE) stage_n<256, 128>(KL, 272, SrcF32{kf + dh * 128, (size_t)1024}, tid); else stage_n<256, 128>(KL, 272, SrcBf16{kvb + dh * 128, (size_t)2048}, tid);
        __syncthreads();
        if (active) {
#pragma unroll
            for (int ks = 0; ks < 4; ++ks) { const int kb = (ks * 32 + 8 * lq) * 2;
#pragma unroll
                for (int y = 0; y < 16; ++y) { sc[y] = MFMA16(frag(KL, 16 * y + l15, 272, kb), qf[dh * 4 + ks], sc[y]); if ((y & 3) == 3) __builtin_amdgcn_sched_barrier(0); } } }
        __syncthreads();
    }
    float inv = 0.f;
    if (active) inv = softmax_rows<16>(sc, PL, l15, lq, -INFINITY);
#pragma unroll 1
    for (int eh = 0; eh < 2; ++eh) {
        if (SAMPLE) stage_t<256, 128>(KL, 528, SrcF32{vf + eh * 128, (size_t)1024}, tid); else stage_t<256, 128>(KL, 528, SrcBf16{kvb + 1024 + eh * 128, (size_t)2048}, tid);
        __syncthreads();
        if (active) {
            f32x4 oa[8];
#pragma unroll
            for (int n = 0; n < 8; ++n) oa[n] = (f32x4){0.f, 0.f, 0.f, 0.f};
#pragma unroll 2
            for (int ks = 0; ks < 8; ++ks) { const int kb = (ks * 32 + 8 * lq) * 2; const bf16x8 xf = frag(PL, l15, 528, kb);
#pragma unroll
                for (int n = 0; n < 8; ++n) oa[n] = MFMA16(frag(KL, 16 * n + l15, 528, kb), xf, oa[n]); }
            if (store_ok) {
#pragma unroll
                for (int n = 0; n < 8; ++n) { u32x2 w; w.x = cvt_pk_bf16(oa[n][0] * inv, oa[n][1] * inv); w.y = cvt_pk_bf16(oa[n][2] * inv, oa[n][3] * inv);
                    *(u32x2*)(O + (size_t)tok * DM + h * 256 + eh * 128 + 16 * n + 4 * lq) = w; } }
        }
        __syncthreads();
    }
}

__device__ __forceinline__ void unit_cross_sample(const Params& P, LAS unsigned char* L, int layer, int item, int tid, int lane, int wave) {
    unsigned char* ws = opq(P.ws); const bf16_t* Q = (const bf16_t*)(ws + WS_Q); bf16_t* O = (bf16_t*)(ws + WS_AB);
    const int l15 = lane & 15, lq = lane >> 4;
    asm volatile("" : "+v"(tid));
    const int h = item & 3, bs = item >> 2; const int tok = NP + bs * 8 + (l15 & 7);
    const float* kf = P.in[5] + ((size_t)(layer * 128 + bs) * 256) * 1024 + h * 256; const float* vf = P.in[6] + ((size_t)(layer * 128 + bs) * 256) * 1024 + h * 256;
    LAS unsigned char* KL = L; LAS unsigned char* PL = L + 36864;
    f32x4 RA[8], RB[8];
#define XS_LOADN(R, base) do { _Pragma("unroll") for (int k = 0; k < 4; ++k) { const int it = tid + 512 * k, r = it >> 3, cq = it & 7; const f32x4* p = (const f32x4*)((base) + (size_t)r * 1024 + cq * 8); R[2 * k] = p[0]; R[2 * k + 1] = p[1]; } } while (0)
#define XS_STOREN(R) do { _Pragma("unroll") for (int k = 0; k < 4; ++k) { const int it = tid + 512 * k, r = it >> 3, cq = it & 7; *(LAS u32x4*)(KL + r * 144 + cq * 16) = pack8(R[2 * k], R[2 * k + 1]); } } while (0)
#define XS_LOADT(R, base) do { _Pragma("unroll") for (int k = 0; k < 2; ++k) { const int it = tid + 512 * k, rp = it & 127, cq = it >> 7; const f32x4* p = (const f32x4*)((base) + (size_t)(2 * rp) * 1024 + cq * 8); \
        R[4 * k] = p[0]; R[4 * k + 1] = p[1]; R[4 * k + 2] = p[256]; R[4 * k + 3] = p[257]; } } while (0)
#define XS_STORET(R) do { _Pragma("unroll") for (int k = 0; k < 2; ++k) { const int it = tid + 512 * k, rp = it & 127, cq = it >> 7; const u32x4 a = pack8(R[4 * k], R[4 * k + 1]), b = pack8(R[4 * k + 2], R[4 * k + 3]); \
        LAS unsigned char* d = KL + (cq * 8) * 528 + rp * 4; _Pragma("unroll") for (int e = 0; e < 4; ++e) { *(LAS unsigned*)(d + (2 * e) * 528) = (a[e] & 0xffffu) | (b[e] << 16); *(LAS unsigned*)(d + (2 * e + 1) * 528) = (a[e] >> 16) | (b[e] & 0xffff0000u); } } } while (0)
#define XS_QK(dq) do { _Pragma("unroll") for (int ks = 0; ks < 2; ++ks) { const int kb = (ks * 32 + 8 * lq) * 2; const bf16x8 qf = *(const bf16x8*)(Q + (size_t)tok * DM + h * 256 + (dq) * 64 + ks * 32 + 8 * lq); \
        sc[0] = MFMA16(frag(KL, 32 * wave + l15, 144, kb), qf, sc[0]); sc[1] = MFMA16(frag(KL, 32 * wave + 16 + l15, 144, kb), qf, sc[1]); } } while (0)
#define XS_PV(eq) do { if (wave < 4) { f32x4 oa = (f32x4){0.f, 0.f, 0.f, 0.f}; \
        _Pragma("unroll") for (int ks = 0; ks < 8; ++ks) { const int kb = (ks * 32 + 8 * lq) * 2; oa = MFMA16(frag(KL, 16 * wave + l15, 528, kb), frag(PL, l15, 528, kb), oa); } \
        if (l15 < 8) { u32x2 w; w.x = cvt_pk_bf16(oa[0] * inv, oa[1] * inv); w.y = cvt_pk_bf16(oa[2] * inv, oa[3] * inv); \
            *(u32x2*)(O + (size_t)tok * DM + h * 256 + (eq) * 64 + 16 * wave + 4 * lq) = w; } } } while (0)
    LAS float* redm = (LAS float*)(L + 36864 + 8448); LAS float* reds = redm + 128;
    f32x4 sc[2]; sc[0] = (f32x4){0.f, 0.f, 0.f, 0.f}; sc[1] = sc[0];
    float inv = 0.f;
    XS_LOADN(RA, kf); XS_LOADN(RB, kf + 64);
    XS_STOREN(RA); XS_LOADN(RA, kf + 128); __syncthreads(); XS_QK(0); __syncthreads();
    XS_STOREN(RB); XS_LOADN(RB, kf + 192); __syncthreads(); XS_QK(1); __syncthreads();
    XS_STOREN(RA); XS_LOADT(RA, vf);       __syncthreads(); XS_QK(2); __syncthreads();
    XS_STOREN(RB); XS_LOADT(RB, vf + 64);  __syncthreads(); XS_QK(3);
    {
        float m = fmaxf(fmaxf(fmaxf(sc[0][0], sc[0][1]), fmaxf(sc[0][2], sc[0][3])), fmaxf(fmaxf(sc[1][0], sc[1][1]), fmaxf(sc[1][2], sc[1][3])));
        m = fmaxf(m, __shfl_xor(m, 16)); m = fmaxf(m, __shfl_xor(m, 32));
        if (lq == 0) redm[wave * 16 + l15] = m;
        __syncthreads();
#pragma unroll
        for (int w = 0; w < 8; ++w) m = fmaxf(m, redm[w * 16 + l15]);
        float ssum = 0.f;
#pragma unroll
        for (int n = 0; n < 2; ++n) { float p[4];
#pragma unroll
            for (int r = 0; r < 4; ++r) { p[r] = fexp(sc[n][r] - m); ssum += p[r]; }
            u32x2 w; w.x = cvt_pk_bf16(p[0], p[1]); w.y = cvt_pk_bf16(p[2], p[3]); *(LAS u32x2*)(PL + l15 * 528 + (32 * wave + 16 * n + 4 * lq) * 2) = w; }
        ssum += __shfl_xor(ssum, 16); ssum += __shfl_xor(ssum, 32);
        if (lq == 0) reds[wave * 16 + l15] = ssum;
    }
    XS_STORET(RA); XS_LOADT(RA, vf + 128); __syncthreads();
    { float t = 0.f;
#pragma unroll
        for (int w = 0; w < 8; ++w) t += reds[w * 16 + l15];
        inv = 1.0f / t; }
    XS_PV(0); __syncthreads();
    XS_STORET(RB); XS_LOADT(RB, vf + 192); __syncthreads(); XS_PV(1); __syncthreads();
    XS_STORET(RA);                         __syncthreads(); XS_PV(2); __syncthreads();
    XS_STORET(RB);                         __syncthreads(); XS_PV(3); __syncthreads();
#undef XS_QK
#undef XS_PV
#undef XS_LOADN
#undef XS_STOREN
#undef XS_LOADT
#undef XS_STORET
}

template <bool SAMPLE> __device__ __forceinline__ void unit_swa(const Params& P, LAS unsigned char* L, int item, int tid, int lane, int wave) {
    constexpr int NKT = 10, NKEY = NKT * 16;
    unsigned char* ws = opq(P.ws); const bf16_t* QKV = (const bf16_t*)(ws + WS_Z); bf16_t* O = (bf16_t*)(ws + WS_AB);
    const int l15 = lane & 15, lq = lane >> 4;
    LAS unsigned char* KL = L; LAS unsigned char* VT = L + 36864; LAS unsigned char* PL = L + 36864 + 33792 + wave * 8448;
    const int kvh = item & 3; int qb = 0, b = 0, bs = 0;
    if (SAMPLE) { bs = item >> 2;
        const float* ck = P.in[3] + ((size_t)bs * 128 * 4 + kvh) * 64; const float* cv = P.in[4] + ((size_t)bs * 128 * 4 + kvh) * 64;
        const bf16_t* nk = QKV + (size_t)(NP + bs * 8) * QKVW + 1024 + kvh * 64; const bf16_t* nv = nk + 256;
        stage_n<128, 64>(KL, 144, SrcF32{ck, (size_t)256}, tid);
        stage_n<32, 64>(KL, 144, SrcTail{nk}, tid, 128);
        stage_t<128, 64>(VT, 528, SrcF32{cv, (size_t)256}, tid);
        stage_t<32, 64>(VT, 528, SrcTail{nv}, tid, 128);
        float* wk = opq(P.out) + O_WKS + ((size_t)bs * 128 * 4 + kvh) * 64; float* wv = opq(P.out) + O_WVS + ((size_t)bs * 128 * 4 + kvh) * 64;
        for (int it = tid; it < 128 * 16; it += 512) { const int w = it >> 4, c4 = (it & 15) * 4, jj = w + 8; f32x4 a, bb;
            if (jj < 128) { a = *(const f32x4*)(ck + (size_t)jj * 256 + c4); bb = *(const f32x4*)(cv + (size_t)jj * 256 + c4); }
            else { const u32x2 ka = *(const u32x2*)(nk + (size_t)(jj - 128) * QKVW + c4), va = *(const u32x2*)(nv + (size_t)(jj - 128) * QKVW + c4);
                a = (f32x4){bf2f(ka.x & 0xffffu), bf2f(ka.x >> 16), bf2f(ka.y & 0xffffu), bf2f(ka.y >> 16)}; bb = (f32x4){bf2f(va.x & 0xffffu), bf2f(va.x >> 16), bf2f(va.y & 0xffffu), bf2f(va.y >> 16)}; }
            *(f32x4*)(wk + (size_t)w * 256 + c4) = a; *(f32x4*)(wv + (size_t)w * 256 + c4) = bb; }
    } else { qb = (item >> 2) & 15; b = item >> 6;
        const bf16_t* kb0 = QKV + ((size_t)b * SEQ + qb * 128 - 128) * QKVW + 1024 + kvh * 64;
        const int zb = qb == 0 ? 128 : 0;
        stage_n<256, 64>(KL, 144, SrcBf16Z{kb0, (size_t)QKVW, zb}, tid);
        stage_t<256, 64>(VT, 528, SrcBf16Z{kb0 + 256, (size_t)QKVW, zb}, tid);
    }
    __syncthreads();
    constexpr int NRT = SAMPLE ? 4 : 32;
    for (int rt = wave; rt < NRT; rt += 8) {
        int g, i, tok;
        if (SAMPLE) { g = rt; i = l15 & 7; tok = NP + bs * 8 + i; }
        else { g = rt >> 3; i = (rt & 7) * 16 + l15; tok = b * SEQ + qb * 128 + i; }
        const int head = kvh * 4 + g;
        const bf16_t* qp = QKV + (size_t)tok * QKVW + head * 64 + 8 * lq;
        const bf16x8 q0 = *(const bf16x8*)qp, q1 = *(const bf16x8*)(qp + 32);
        const int ylo = SAMPLE ? 0 : (wave > 0 ? wave - 1 : 0);
        f32x4 sc[NKT];
#pragma unroll
        for (int y = 0; y < NKT; ++y) { sc[y] = (f32x4){0.f, 0.f, 0.f, 0.f};
            sc[y] = MFMA16(frag(KL, 16 * (ylo + y) + l15, 144, (8 * lq) * 2), q0, sc[y]); sc[y] = MFMA16(frag(KL, 16 * (ylo + y) + l15, 144, (32 + 8 * lq) * 2), q1, sc[y]);
            if ((y & 1) == 1) __builtin_amdgcn_sched_barrier(0); }
        const int jlo = (!SAMPLE && qb == 0) ? 128 : 0;
#pragma unroll
        for (int y = 0; y < NKT; ++y)
#pragma unroll
            for (int r = 0; r < 4; ++r) { const int jj = 16 * (ylo + y) + 4 * lq + r; const bool valid = (jj > i) && (jj <= i + 128) && (jj >= jlo); sc[y][r] = valid ? sc[y][r] * 0.125f : -INFINITY; }
        const float sink = P.in[17][head];
        const float inv = softmax_rows<NKT>(sc, PL, l15, lq, sink);
        asm volatile("s_waitcnt lgkmcnt(0)" ::: "memory");
        f32x4 oa[4];
#pragma unroll
        for (int n = 0; n < 4; ++n) oa[n] = (f32x4){0.f, 0.f, 0.f, 0.f};
#pragma unroll 2
        for (int ks = 0; ks < NKT / 2; ++ks) { const int kb = (ks * 32 + 8 * lq) * 2; const bf16x8 xf = frag(PL, l15, 528, kb);
#pragma unroll
            for (int n = 0; n < 4; ++n) oa[n] = MFMA16(frag(VT, 16 * n + l15, 528, kb + 32 * ylo), xf, oa[n]); }
        if (!SAMPLE || l15 < 8) {
#pragma unroll
            for (int n = 0; n < 4; ++n) { u32x2 w; w.x = cvt_pk_bf16(oa[n][0] * inv, oa[n][1] * inv); w.y = cvt_pk_bf16(oa[n][2] * inv, oa[n][3] * inv);
                *(u32x2*)(O + (size_t)tok * DM + head * 64 + 16 * n + 4 * lq) = w; } }
        asm volatile("s_waitcnt lgkmcnt(0)" ::: "memory");
    }
}

__device__ __forceinline__ void unit_swa_sample(const Params& P, LAS unsigned char* L, int item, int tid, int lane, int wave) {
    unsigned char* ws = opq(P.ws); const bf16_t* QKV = (const bf16_t*)(ws + WS_Z); bf16_t* O = (bf16_t*)(ws + WS_AB);
    asm volatile("" : "+v"(tid));
    const int kvh = item & 3, bs = item >> 2;
    LAS float* Kf = (LAS float*)L;
    LAS float* Vf = (LAS float*)(L + 36992);
    LAS float* Qf = (LAS float*)(L + 36992 + 34816);
    LAS float* Pf = (LAS float*)(L + 36992 + 34816 + 8192);
    const float* ck = P.in[3] + ((size_t)bs * 128 * 4 + kvh) * 64; const float* cv = P.in[4] + ((size_t)bs * 128 * 4 + kvh) * 64;
    const bf16_t* nk = QKV + (size_t)(NP + bs * 8) * QKVW + 1024 + kvh * 64; const bf16_t* nv = nk + 256;
    float* wk = opq(P.out) + O_WKS + ((size_t)bs * 128 * 4 + kvh) * 64; float* wv = opq(P.out) + O_WVS + ((size_t)bs * 128 * 4 + kvh) * 64;
    for (int it = tid; it < 136 * 16; it += 512) { const int jj = it >> 4, d = (it & 15) * 4; f32x4 kx, vx;
        if (jj < 128) { kx = *(const f32x4*)(ck + (size_t)jj * 256 + d); vx = *(const f32x4*)(cv + (size_t)jj * 256 + d); }
        else { const u32x2 ka = *(const u32x2*)(nk + (size_t)(jj - 128) * QKVW + d), va = *(const u32x2*)(nv + (size_t)(jj - 128) * QKVW + d);
            kx = (f32x4){bf2f(ka.x & 0xffffu), bf2f(ka.x >> 16), bf2f(ka.y & 0xffffu), bf2f(ka.y >> 16)}; vx = (f32x4){bf2f(va.x & 0xffffu), bf2f(va.x >> 16), bf2f(va.y & 0xffffu), bf2f(va.y >> 16)}; }
        *(LAS f32x4*)(Kf + jj * 68 + d) = kx; *(LAS f32x4*)(Vf + jj * 64 + d) = vx;
        if (jj >= 8) { *(f32x4*)(wk + (size_t)(jj - 8) * 256 + d) = kx; *(f32x4*)(wv + (size_t)(jj - 8) * 256 + d) = vx; } }
    { const int r = tid >> 4, d = (tid & 15) * 4, g = r >> 3, i = r & 7;
        const u32x2 qa = *(const u32x2*)(QKV + (size_t)(NP + bs * 8 + i) * QKVW + (kvh * 4 + g) * 64 + d);
        *(LAS f32x4*)(Qf + r * 64 + d) = (f32x4){bf2f(qa.x & 0xffffu), bf2f(qa.x >> 16), bf2f(qa.y & 0xffffu), bf2f(qa.y >> 16)}; }
    __syncthreads();
    for (int idx = tid; idx < 32 * 136; idx += 512) { const int r = idx / 136, jj = idx - r * 136, i = r & 7; f32x4 sa = (f32x4){0.f, 0.f, 0.f, 0.f};
#pragma unroll 4
        for (int d = 0; d < 64; d += 4) sa += *(const LAS f32x4*)(Qf + r * 64 + d) * *(const LAS f32x4*)(Kf + jj * 68 + d);
        const float sacc = (sa[0] + sa[1]) + (sa[2] + sa[3]);
        Pf[r * 144 + jj] = ((jj > i) && (jj <= i + 128)) ? sacc * 0.125f : -INFINITY; }
    __syncthreads();
    const int r = tid >> 4, t = tid & 15, g = r >> 3, i = r & 7, head = kvh * 4 + g;
    const float sink = P.in[17][head];
    float m = sink;
    for (int jj = t; jj < 136; jj += 16) m = fmaxf(m, Pf[r * 144 + jj]);
#pragma unroll
    for (int o = 1; o < 16; o <<= 1) m = fmaxf(m, __shfl_xor(m, o));
    float ssum = 0.f;
    for (int jj = t; jj < 136; jj += 16) { const float p = fexp(Pf[r * 144 + jj] - m); Pf[r * 144 + jj] = p; ssum += p; }
#pragma unroll
    for (int o = 1; o < 16; o <<= 1) ssum += __shfl_xor(ssum, o);
    const float inv = 1.0f / (ssum + fexp(sink - m));
    __syncthreads();
    f32x4 oacc = (f32x4){0.f, 0.f, 0.f, 0.f};
#pragma unroll 4
    for (int jj = 0; jj < 136; jj += 4) { const f32x4 p = *(const LAS f32x4*)(Pf + r * 144 + jj);
        oacc += *(const LAS f32x4*)(Vf + jj * 64 + 4 * t) * p[0]; oacc += *(const LAS f32x4*)(Vf + (jj + 1) * 64 + 4 * t) * p[1];
        oacc += *(const LAS f32x4*)(Vf + (jj + 2) * 64 + 4 * t) * p[2]; oacc += *(const LAS f32x4*)(Vf + (jj + 3) * 64 + 4 * t) * p[3]; }
    u32x2 w; w.x = cvt_pk_bf16(oacc[0] * inv, oacc[1] * inv); w.y = cvt_pk_bf16(oacc[2] * inv, oacc[3] * inv);
    *(u32x2*)(O + (size_t)(NP + bs * 8 + i) * DM + head * 64 + 4 * t) = w;
}

__device__ __forceinline__ void phase_final(const Params& P, int lane, int wave) {
    const bf16_t* XB = (const bf16_t*)(opq(P.ws) + WS_XN); const float* rss = (const float*)(opq(P.ws) + WS_RSS); const float* g = P.in[29]; float* Y = opq(P.out) + O_Y;
    const int gw = blockIdx.x * 8 + wave, NGW = gridDim.x * 8;
    f32x4 gg[4];
#pragma unroll
    for (int j = 0; j < 4; ++j) gg[j] = *(const f32x4*)(g + 8 * lane + 512 * (j >> 1) + 4 * (j & 1));
    for (int row = gw; row < NTOK; row += NGW) { const float r = rss_scale(rss, row);
#pragma unroll
        for (int j = 0; j < 2; ++j) { const int c = 8 * lane + 512 * j; f32x4 a, b; pg8::unpack8(*(const u32x4*)(XB + (size_t)row * DM + c), a, b);
            __builtin_nontemporal_store(a * r * gg[2 * j], (f32x4*)(Y + (size_t)row * DM + c)); __builtin_nontemporal_store(b * r * gg[2 * j + 1], (f32x4*)(Y + (size_t)row * DM + c + 4)); } }
}

constexpr int NPHASE = 21;
__global__ void __launch_bounds__(512) fwd_kernel(Params P) {
    extern __shared__ __attribute__((aligned(16))) unsigned char lds_raw[];
    LAS unsigned char* L = (LAS unsigned char*)lds_raw;
    const int G = gridDim.x, bx = blockIdx.x;
    const int lo = P.ph_lo, hi = P.ph_hi;
    if (threadIdx.x < 2) ((LAS unsigned*)(L + SLOT_OFF + 16))[threadIdx.x] = 0u;
    __syncthreads();
    XcdBarrier xbar; xbar.bar = (unsigned*)(P.ws + WS_CTL) + 4096; xbar.x = 0; xbar.st = (volatile LAS unsigned*)(L + SLOT_OFF + 16);
    if (hi - lo > 1) xbar = xcd_barrier_post((unsigned*)(P.ws + WS_CTL) + 4096, (volatile LAS unsigned*)(L + SLOT_OFF + 16));
    using pg8::Gemm; using pg8::StaticOrder; using pg8::EpiAct; using pg8::EpiRes; using pg8::EpiMem;
#ifndef PHASE_MASK
#define PHASE_MASK 0x1fffff
#endif
    const int rp = (P.pmask >> 21) & 31, rc = (P.pmask >> 26) & 7;
#pragma unroll 1
    for (int step = lo; step < hi + rc; ++step) {
        const int ph = step <= rp ? step : (step <= rp + rc ? rp : step - rc);
        const int rep = step <= rp ? 0 : (step <= rp + rc ? step - rp : 0);
        int tid = threadIdx.x; asm volatile("" : "+v"(tid));
        const int lane = tid & 63, wave = __builtin_amdgcn_readfirstlane(tid >> 6);
        unsigned char* ws = opq(P.ws);
        unsigned* ctl = (unsigned*)(ws + WS_CTL);
        bf16_t* XN = (bf16_t*)(ws + WS_XN); float* rss = (float*)(ws + WS_RSS);
        bf16_t* Z = (bf16_t*)(ws + WS_Z); bf16_t* AB = (bf16_t*)(ws + WS_AB); bf16_t* Qb = (bf16_t*)(ws + WS_Q);
        if (((PHASE_MASK & P.pmask) >> ph) & 1) {
            int kind = 0;
            const bf16_t* A = XN; const bf16_t* Bt = nullptr; int N = DM, K = 1024;
            bf16_t* Optr = Z; int ldc = DM; const float* biasp = nullptr; float scale = 1.0f; int act = 0, actc = 0;
            const float* xa = nullptr; const float* xb = nullptr; int split = NTOK;
            const int l = ph >= 15 ? 1 : 0;
            switch (ph) {
                case 1: kind = 1; Bt = (const bf16_t*)(ws + WS_WIN); N = ZW; Optr = Z; ldc = ZW; act = 1; actc = 2048; break;
                case 5: kind = 2; A = AB; Bt = (const bf16_t*)(ws + WS_WOUTE); K = 2048; xa = P.in[0]; xb = P.in[1]; split = NP; break;
                case 6: case 15: kind = 1; Bt = (const bf16_t*)(ws + WS_WMQ + l * 2 * MiB); Optr = Qb; scale = 0.0625f; break;
                case 8: case 17: kind = 2; A = AB; Bt = (const bf16_t*)(ws + WS_WMO + l * 2 * MiB); break;
                case 9: case 18: kind = 1; Bt = (const bf16_t*)(ws + WS_WUP + l * 8 * MiB); N = FF; Optr = Z; ldc = FF; act = 2; break;
                case 10: case 19: kind = 2; A = Z; Bt = (const bf16_t*)(ws + WS_WDOWN + l * 8 * MiB); K = 4096; break;
                case 11: kind = 1; Bt = (const bf16_t*)(ws + WS_WQKV); N = QKVW; Optr = Z; ldc = QKVW; biasp = P.in[16]; break;
                case 14: kind = 2; A = AB; Bt = (const bf16_t*)(ws + WS_WOUTO); biasp = P.in[19]; break;
                default: break;
            }
            if (kind == 1) {
                const bool all_big = (ph == 11 || ph == 1 || ph == 9 || ph == 18);
                const int Mbig = all_big ? NTOK : NP;
                Gemm g{A, Bt, Mbig, N, K}; StaticOrder S; S.init(Mbig, N, G, bx);
                EpiAct E{Optr, ldc, rss, biasp, scale, act, actc}; pg8::gemm_phase<EpiAct, StaticOrder, true, true>(L, g, S, E, tid);
                if (!all_big) gemm_small(L, A + (size_t)NP * K, Bt, N, K, RowAct{Optr, ldc, rss, biasp, scale, act, actc}, tid, lane, wave);
                if (ph == 1) {
#pragma unroll 1
                    for (int ll = 0; ll < 2; ++ll) { Gemm g2{(const bf16_t*)(ws + WS_MN + ll * 4 * MiB), (const bf16_t*)(ws + WS_WMKV + ll * 4 * MiB), 2048, 2048, 1024}; StaticOrder S2; S2.init(2048, 2048, G, ((bx - 80 - 64 * ll) % G + G) % G);
                        EpiMem E2{opq(P.out) + O_MEMK + (size_t)ll * 2048 * 1024, opq(P.out) + O_MEMV + (size_t)ll * 2048 * 1024, (bf16_t*)(ws + WS_MKV + ll * 8 * MiB)}; pg8::gemm_phase<EpiMem, StaticOrder, true, true>(L, g2, S2, E2, tid); }
                }
            } else if (kind == 2) {
                Gemm g{A, Bt, NP, DM, K}; StaticOrder S; S.init(NP, DM, G, bx);
                EpiRes E{xa, xb, split, XN, biasp, rss}; pg8::gemm_phase<EpiRes, StaticOrder, true, true>(L, g, S, E, tid);
                gemm_small(L, A + (size_t)NP * K, Bt, DM, K, RowRes{xa, xb, split, XN, biasp, rss}, tid, lane, wave);
            } else if (ph == 0) { phase_prologue(P, L, tid, lane, wave);
            } else if (ph == 2) { phase_rowpass_a(P, lane, wave);
            } else if (ph == 3) {
                for (;;) { const int it = next_item(ctl + 64 * (3 + 32 * rep), L); if (it >= 1280) break;
                    const int sel = rep ? ((P.pmask >> 29) & 3) : 0;
                    if (it < 128) { if (sel == 0 || sel == 1) unit_scan(P, L, it, tid, lane, wave); }
                    else if (it < 640) { if (sel == 0 || sel == 2) unit_sgu(P, L, it - 128, tid, lane, wave); }
                    else if (it < 1152) { if (sel == 0 || sel == 3) unit_ret_sample(P, L, it - 640, tid, lane, wave); }
                    else unit_sgu_sample(P, it - 1152, tid); }
            } else if (ph == 4) { for (;;) { const int it = next_item(ctl + 64 * (4 + 32 * rep), L); if (it >= 512) break; unit_ret_out(P, L, it, tid, lane, wave); }
            } else if (ph == 7 || ph == 16) { for (;;) { const int it = next_item(ctl + 64 * (ph + 32 * rep), L); if (it >= 1024) break;
                    const int sel = rep ? ((P.pmask >> 29) & 3) : 0;
                    if (it & 1) { if (sel != 2) unit_cross_sample(P, L, l, it >> 1, tid, lane, wave); } else { if (sel != 1) unit_cross<false>(P, L, l, it >> 1, tid, lane, wave); } }
            } else if (ph == 12) { phase_rowpass_b(P, lane, wave);
            } else if (ph == 13) { for (;;) { const int it = next_item(ctl + 64 * (13 + 32 * rep), L); if (it >= 1024) break;
                    const int sel = rep ? ((P.pmask >> 29) & 3) : 0;
                    if (it & 1) { if (sel != 2) unit_swa_sample(P, L, it >> 1, tid, lane, wave); } else { if (sel != 1) unit_swa<false>(P, L, it >> 1, tid, lane, wave); } }
            } else if (ph == 20) { phase_final(P, lane, wave); }
        }
        if (step + 1 < hi + rc) {
            if (P.ph_lo < 0) cg::this_grid().sync();
            xcd_barrier(xbar);
        }
    }
}

extern "C" void kernel_launch(void* const* d_in, const int* in_sizes, int n_in, void* d_out, int out_size, void* d_ws, size_t ws_size, hipStream_t stream) {
    static int grid = 0;
    if (grid == 0) {
        if (n_in != 30 || ws_size < WS_END) { fprintf(stderr, "kernel_launch: unexpected problem (n_in %d, ws %zu)\n", n_in, ws_size); grid = -1; return; }
        int dev = 0, cus = 0, per_cu = 0;
        (void)hipGetDevice(&dev); (void)hipDeviceGetAttribute(&cus, hipDeviceAttributeMultiprocessorCount, dev);
        if (hipFuncSetAttribute((const void*)fwd_kernel, hipFuncAttributeMaxDynamicSharedMemorySize, LDS_BYTES) != hipSuccess) { fprintf(stderr, "kernel_launch: hipFuncSetAttribute failed\n"); }
        if (hipOccupancyMaxActiveBlocksPerMultiprocessor(&per_cu, (const void*)fwd_kernel, 512, LDS_BYTES) != hipSuccess || per_cu < 1) { fprintf(stderr, "kernel_launch: occupancy query says %d\n", per_cu); per_cu = 1; }
        (void)hipGetLastError();
        grid = cus * 1;
        fprintf(stderr, "kernel_launch: cus %d per_cu %d grid %d\n", cus, per_cu, grid);
    }
    if (grid < 0) return;
    (void)hipMemsetAsync((char*)d_ws + WS_CTL, 0, CTL_BYTES, stream);
    if ((RUN_MASK >> 30) & 1) (void)hipMemsetAsync(d_out, 0, (size_t)out_size * 4, stream);
    Params p{};
    for (int i = 0; i < 30; ++i) p.in[i] = (const float*)d_in[i];
    p.out = (float*)d_out; p.ws = (unsigned char*)d_ws; p.pmask = RUN_MASK | (REP_PHASE << 21) | (REP_COUNT << 26) | (REP_SEL << 29);
    for (int j = 0; j < 64; ++j) p.inv[j] = powf(10000.0f, -(float)j / 64.0f);
    for (int j = 0; j < 32; ++j) p.inv[64 + j] = powf(150000.0f, -(float)j / 32.0f);
#if MK_ONE_LAUNCH
    p.ph_lo = 0; p.ph_hi = NPHASE;
    void* args[] = {&p};
    hipError_t e = hipLaunchCooperativeKernel((const void*)fwd_kernel, dim3(grid), dim3(512), args, LDS_BYTES, stream);
    if (e != hipSuccess) fprintf(stderr, "kernel_launch: cooperative launch failed: %s\n", hipGetErrorString(e));
#else
    for (int ph = 0; ph < NPHASE; ++ph) { p.ph_lo = ph; p.ph_hi = ph + 1; hipLaunchKernelGGL(fwd_kernel, dim3(grid), dim3(512), LDS_BYTES, stream, p); }
#endif
}
```
